# Optimizing an MI355X kernel written in HIP

```python
import math
import jax, jax.numpy as jnp
from jax import lax
import numpy as np

D_MODEL = 1024
BATCH = 4
SEQ = 4096
DEPTH = 1

D_MIX = D_MODEL
N_ATTN_HEADS = 8
ATTN_HEAD_DIM = 64
D_ATTN = N_ATTN_HEADS * ATTN_HEAD_DIM
D_POOL = D_MIX - D_ATTN
POOL_WINDOWS = (2, 4, 8, 16)
N_POOL_GROUPS = len(POOL_WINDOWS)
POOL_GROUP_DIM = D_POOL // N_POOL_GROUPS
D_IN = 3 * D_ATTN + D_POOL
MOBA_BLOCK = 256
MOBA_TOPK = 3
Q_CHUNK = 32
N_MEM = 256
XA_HEADS = 4
XA_HEAD_DIM = D_MODEL // XA_HEADS
D_FF = 2816
MACARON_WEIGHT = 0.5
RMS_EPS = 1e-6

kernel_name = "hybrid_moba_pool_macaron_block"


def rmsnorm(x, g):
    xf = x.astype(jnp.float32)
    r = lax.rsqrt(jnp.mean(xf * xf, axis=-1, keepdims=True) + RMS_EPS)
    return (xf * r).astype(x.dtype) * g


def swiglu(h, w_gate, w_up, w_down):
    return (jax.nn.silu(h @ w_gate) * (h @ w_up)) @ w_down


def alibi_slopes(n_heads):
    s = 2.0 ** (-8.0 * np.arange(1, n_heads + 1) / n_heads)
    return jnp.asarray(s, dtype=jnp.float32)


def moba_attention(q, k, v, slopes):
    B, H, S, dh = q.shape
    L = MOBA_BLOCK
    s_pad = ((S + L - 1) // L) * L
    pad = s_pad - S
    kp = jnp.pad(k, ((0, 0), (0, 0), (0, pad), (0, 0)))
    vp = jnp.pad(v, ((0, 0), (0, 0), (0, pad), (0, 0)))
    nb = s_pad // L
    n_sel = min(MOBA_TOPK, nb)
    kb = kp.reshape(B, H, nb, L, dh)
    vb = vp.reshape(B, H, nb, L, dh)
    k_mean = jnp.mean(kb, axis=3)
    qs = q * (dh ** -0.5)
    bi = jnp.arange(B)[:, None, None, None]
    hi = jnp.arange(H)[None, :, None, None]
    lpos = jnp.arange(L)
    slot = jnp.arange(n_sel)
    blk_ids = jnp.arange(nb)
    n_chunks = S // Q_CHUNK

    def chunk(c):
        start = c * Q_CHUNK
        qc = lax.dynamic_slice_in_dim(qs, start, Q_CHUNK, axis=2)
        qpos = start + jnp.arange(Q_CHUNK)
        qpos_f = qpos.astype(jnp.float32)
        own = start // L
        gate = jnp.einsum('bhqd,bhnd->bhqn', qc, k_mean).astype(jnp.float32)
        gate = jnp.where(blk_ids < own, gate, -jnp.inf)
        _, idx = lax.top_k(gate, n_sel)
        slot_ok = slot < own
        k_sel = kb[bi, hi, idx]
        v_sel = vb[bi, hi, idx]
        kpos_sel = (idx[..., None] * L + lpos).astype(jnp.float32)
        s_sel = (jnp.einsum('bhqd,bhqrld->bhqrl', qc, k_sel).astype(jnp.float32)
                 - slopes[:, None, None, None] * (qpos_f[:, None, None] - kpos_sel))
        s_sel = jnp.where(slot_ok[:, None], s_sel, -jnp.inf)
        k_own = lax.dynamic_index_in_dim(kb, own, axis=2, keepdims=False)
        v_own = lax.dynamic_index_in_dim(vb, own, axis=2, keepdims=False)
        kpos_own = own * L + lpos
        s_own = (jnp.einsum('bhqd,bhld->bhql', qc, k_own).astype(jnp.float32)
                 - slopes[:, None, None] * (qpos_f[:, None] - kpos_own.astype(jnp.float32)[None, :]))
        s_own = jnp.where(kpos_own[None, :] <= qpos[:, None], s_own, -jnp.inf)
        scores = jnp.concatenate([s_sel.reshape(B, H, Q_CHUNK, n_sel * L), s_own], axis=-1)
        p = jax.nn.softmax(scores, axis=-1)
        p_sel = p[..., :n_sel * L].reshape(B, H, Q_CHUNK, n_sel, L).astype(v.dtype)
        p_own = p[..., n_sel * L:].astype(v.dtype)
        return (jnp.einsum('bhqrl,bhqrld->bhqd', p_sel, v_sel)
                + jnp.einsum('bhql,bhld->bhqd', p_own, v_own))

    outs = lax.map(chunk, jnp.arange(n_chunks))
    return outs.transpose(1, 2, 0, 3, 4).reshape(B, H, S, dh)


def multiscale_pool(p, pool_w, pool_scale):
    B, S, C = p.shape
    pf = p.reshape(B, S, N_POOL_GROUPS, POOL_GROUP_DIM).astype(jnp.float32)
    cs = jnp.concatenate([jnp.zeros((B, 1, N_POOL_GROUPS, POOL_GROUP_DIM), jnp.float32),
                          lax.cumsum(pf, axis=1)], axis=1)
    t = jnp.arange(S)
    outs = []
    for g, w in enumerate(POOL_WINDOWS):
        lo = jnp.maximum(t + 1 - w, 0)
        cnt = (t + 1 - lo).astype(jnp.float32)
        mean = (cs[:, 1:, g] - cs[:, lo, g]) / cnt[None, :, None]
        outs.append(mean - pf[:, :, g])
    d = jnp.stack(outs, axis=2).astype(p.dtype)
    y = jnp.einsum('bsgc,gcd->bsgd', d, pool_w)
    return y.reshape(B, S, C) * pool_scale


def memory_cross_attention(h, mem_n, wq, wkv, wo):
    B, S, _ = h.shape
    M = mem_n.shape[1]
    q = (h @ wq).reshape(B, S, XA_HEADS, XA_HEAD_DIM)
    kv = mem_n @ wkv
    k = kv[..., :D_MODEL].reshape(B, M, XA_HEADS, XA_HEAD_DIM)
    v = kv[..., D_MODEL:].reshape(B, M, XA_HEADS, XA_HEAD_DIM)
    s = jnp.einsum('bshd,bmhd->bhsm', q, k).astype(jnp.float32) * (XA_HEAD_DIM ** -0.5)
    p = jax.nn.softmax(s, axis=-1).astype(v.dtype)
    o = jnp.einsum('bhsm,bmhd->bshd', p, v).reshape(B, S, XA_HEADS * XA_HEAD_DIM)
    return o @ wo


def setup_inputs(seed: int = 0) -> dict:
    key = jax.random.key(seed)
    ks = jax.random.split(key, 24)

    def nrm(k, shape, fan_in):
        return jax.random.normal(k, shape, jnp.float32) * fan_in ** -0.5

    def gain(k, shape):
        return 1.0 + 0.1 * jax.random.normal(k, shape, jnp.float32)

    L = DEPTH
    return {
        "x": jax.random.normal(ks[0], (BATCH, SEQ, D_MODEL), jnp.float32),
        "mem": jax.random.normal(ks[1], (BATCH, N_MEM, D_MODEL), jnp.float32),
        "ffn1_pre_g": gain(ks[2], (L, D_MODEL)),
        "ffn1_w_gate": nrm(ks[3], (L, D_MODEL, D_FF), D_MODEL),
        "ffn1_w_up": nrm(ks[4], (L, D_MODEL, D_FF), D_MODEL),
        "ffn1_w_down": nrm(ks[5], (L, D_FF, D_MODEL), D_FF),
        "ffn1_post_g": gain(ks[6], (L, D_MODEL)),
        "mix_pre_g": gain(ks[7], (L, D_MODEL)),
        "w_in": nrm(ks[8], (L, D_MODEL, D_IN), D_MODEL),
        "pool_w": nrm(ks[9], (L, N_POOL_GROUPS, POOL_GROUP_DIM, POOL_GROUP_DIM), POOL_GROUP_DIM),
        "pool_scale": gain(ks[10], (L, D_POOL)),
        "w_out": nrm(ks[11], (L, D_MIX, D_MODEL), D_MIX),
        "mix_post_g": gain(ks[12], (L, D_MODEL)),
        "xa_pre_g": gain(ks[13], (L, D_MODEL)),
        "mem_g": gain(ks[14], (L, D_MODEL)),
        "xa_wq": nrm(ks[15], (L, D_MODEL, XA_HEADS * XA_HEAD_DIM), D_MODEL),
        "xa_wkv": nrm(ks[16], (L, D_MODEL, 2 * XA_HEADS * XA_HEAD_DIM), D_MODEL),
        "xa_wo": nrm(ks[17], (L, XA_HEADS * XA_HEAD_DIM, D_MODEL), XA_HEADS * XA_HEAD_DIM),
        "xa_post_g": gain(ks[18], (L, D_MODEL)),
        "ffn2_pre_g": gain(ks[19], (L, D_MODEL)),
        "ffn2_w_gate": nrm(ks[20], (L, D_MODEL, D_FF), D_MODEL),
        "ffn2_w_up": nrm(ks[21], (L, D_MODEL, D_FF), D_MODEL),
        "ffn2_w_down": nrm(ks[22], (L, D_FF, D_MODEL), D_FF),
        "ffn2_post_g": gain(ks[23], (L, D_MODEL)),
    }


def reference(x, mem, ffn1_pre_g, ffn1_w_gate, ffn1_w_up, ffn1_w_down, ffn1_post_g,
              mix_pre_g, w_in, pool_w, pool_scale, w_out, mix_post_g,
              xa_pre_g, mem_g, xa_wq, xa_wkv, xa_wo, xa_post_g,
              ffn2_pre_g, ffn2_w_gate, ffn2_w_up, ffn2_w_down, ffn2_post_g):
    B, S, _ = x.shape
    slopes = alibi_slopes(N_ATTN_HEADS)
    for l in range(DEPTH):
        h = rmsnorm(x, ffn1_pre_g[l])
        f = swiglu(h, ffn1_w_gate[l], ffn1_w_up[l], ffn1_w_down[l])
        x = x + MACARON_WEIGHT * rmsnorm(f, ffn1_post_g[l])

        h = rmsnorm(x, mix_pre_g[l])
        proj = h @ w_in[l]
        q = proj[..., :D_ATTN]
        k = proj[..., D_ATTN:2 * D_ATTN]
        v = proj[..., 2 * D_ATTN:3 * D_ATTN]
        p_in = proj[..., 3 * D_ATTN:]
        to_heads = lambda t: t.reshape(B, S, N_ATTN_HEADS, ATTN_HEAD_DIM).transpose(0, 2, 1, 3)
        attn = moba_attention(to_heads(q), to_heads(k), to_heads(v), slopes)
        attn = attn.transpose(0, 2, 1, 3).reshape(B, S, D_ATTN)
        pool = multiscale_pool(p_in, pool_w[l], pool_scale[l])
        y = jnp.concatenate([attn, pool], axis=-1) @ w_out[l]
        x = x + rmsnorm(y, mix_post_g[l])

        h = rmsnorm(x, xa_pre_g[l])
        mem_n = rmsnorm(mem, mem_g[l])
        c = memory_cross_attention(h, mem_n, xa_wq[l], xa_wkv[l], xa_wo[l])
        x = x + rmsnorm(c, xa_post_g[l])

        h = rmsnorm(x, ffn2_pre_g[l])
        f = swiglu(h, ffn2_w_gate[l], ffn2_w_up[l], ffn2_w_down[l])
        x = x + MACARON_WEIGHT * rmsnorm(f, ffn2_post_g[l])
    return x
```

```cpp
#include <hip/hip_runtime.h>
#include <cstdio>
#include <cstdint>

typedef unsigned short u16;
typedef _Float16 h8 __attribute__((ext_vector_type(8)));
typedef _Float16 h2 __attribute__((ext_vector_type(2)));
typedef float f32x2 __attribute__((ext_vector_type(2)));
typedef float f32x4 __attribute__((ext_vector_type(4)));
typedef float f32x16 __attribute__((ext_vector_type(16)));
typedef unsigned u32x4 __attribute__((ext_vector_type(4)));
typedef unsigned u32x2 __attribute__((ext_vector_type(2)));

constexpr int BATCH = 4, SEQ = 4096, DM = 1024, M = BATCH * SEQ;
constexpr int NH = 8, HD = 64, DATT = 512, DPOOL = 512, DIN = 2048;
constexpr int LBLK = 256, NBLK = SEQ / LBLK;
constexpr int NMEM = 256, XH = 4, XHD = 256;
constexpr int DFF = 2816;
constexpr float EPS = 1e-6f;
constexpr float LOG2E = 1.4426950408889634f;
constexpr float QSCALE = 0.125f * LOG2E;
constexpr float XQSCALE = 0.0625f * LOG2E;

constexpr size_t MiB = 1u << 20;
constexpr size_t WS_CTL = 0, CTL_BYTES = 1 * MiB;
constexpr size_t WS_KMEAN = 1 * MiB;
constexpr size_t WS_XBUF = 2 * MiB;
constexpr size_t WS_MEMN = 5 * MiB;
constexpr size_t WS_KMEM = 7 * MiB;
constexpr size_t WS_VMEMT = 9 * MiB;
constexpr size_t WS_WPT = 11 * MiB;
constexpr size_t WS_W1A = 12 * MiB;
constexpr size_t WS_W1D = 23 * MiB;
constexpr size_t WS_W2A = WS_W1D + 5 * MiB + MiB / 2;
constexpr size_t WS_W2D = WS_W2A + 11 * MiB;
constexpr size_t WS_WIN = 45 * MiB;
constexpr size_t WS_WOUT = 49 * MiB;
constexpr size_t WS_WQ = 51 * MiB;
constexpr size_t WS_WKV = 53 * MiB;
constexpr size_t WS_WO = 57 * MiB;
constexpr size_t WS_XN = 60 * MiB;
constexpr size_t WS_R1 = 92 * MiB;
constexpr size_t WS_ACT = WS_R1, WS_PROJ = WS_R1, WS_XQ = WS_R1, WS_XP = WS_R1 + 32 * MiB, WS_F32B = WS_R1;
constexpr size_t WS_R2 = 180 * MiB;
constexpr size_t WS_MIX = WS_R2, WS_XAO = WS_R2 + 32 * MiB, WS_F32A = WS_R2;
constexpr size_t WS_END = 244 * MiB;

__device__ __forceinline__ float h2f(u16 v) { return (float)__builtin_bit_cast(_Float16, v); }
__device__ __forceinline__ u16 f2h(float f) { return __builtin_bit_cast(u16, (_Float16)f); }
__device__ __forceinline__ unsigned pk2h(float lo, float hi) { f32x2 v = {lo, hi}; h2 h = __builtin_convertvector(v, h2); return __builtin_bit_cast(unsigned, h); }
__device__ __forceinline__ float wave_sum(float v) {
#pragma unroll
    for (int o = 1; o < 64; o <<= 1) v += __shfl_xor(v, o);
    return v;
}
__device__ __forceinline__ float wave_max(float v) {
#pragma unroll
    for (int o = 1; o < 64; o <<= 1) v = fmaxf(v, __shfl_xor(v, o));
    return v;
}

struct Ptrs {
    const float* in[24];
    float* out;
    unsigned char* ws;
};

__device__ __forceinline__ int rowmap(int map, int n) { return map == 0 ? n : ((n >> 7) * 256 + (map == 2 ? 128 : 0) + (n & 127)); }
__device__ __forceinline__ void transpose_item(const float* W, int K, int N, u16* WT, int map, float* scr, int item, int lane) {
    const int nblk = N / 32, kb = item / nblk, nb = item % nblk, k0 = 64 * kb, n0 = 32 * nb;
#pragma unroll 8
    for (int i = 0; i < 32; ++i) { const int kk = 2 * i + (lane >> 5); scr[kk * 33 + (lane & 31)] = W[(size_t)(k0 + kk) * N + n0 + (lane & 31)]; }
    asm volatile("s_waitcnt lgkmcnt(0)" ::: "memory");
    const int c = lane & 7;
    const int r0 = rowmap(map, n0);
#pragma unroll
    for (int j = 0; j < 4; ++j) { const int n = (lane >> 3) + 8 * j; const float* s = scr + (8 * c) * 33 + n;
        u32x4 o; o.x = pk2h(s[0 * 33], s[1 * 33]); o.y = pk2h(s[2 * 33], s[3 * 33]); o.z = pk2h(s[4 * 33], s[5 * 33]); o.w = pk2h(s[6 * 33], s[7 * 33]);
        *(u32x4*)(WT + (size_t)(r0 + n) * K + k0 + 8 * c) = o; }
    asm volatile("s_waitcnt lgkmcnt(0)" ::: "memory");
}
__device__ __forceinline__ void rms_row_to_f16(const float* xrow, const float* g, u16* orow, int lane) {
    const f32x4* xr = (const f32x4*)xrow + lane; const f32x4* gr = (const f32x4*)g + lane;
    f32x4 v[4]; float s = 0.f;
#pragma unroll
    for (int j = 0; j < 4; ++j) { v[j] = xr[64 * j]; s += (v[j].x * v[j].x + v[j].y * v[j].y) + (v[j].z * v[j].z + v[j].w * v[j].w); }
    const float r = 1.0f / sqrtf(wave_sum(s) * (1.f / DM) + EPS);
    u32x2* o8 = (u32x2*)orow + lane;
#pragma unroll
    for (int j = 0; j < 4; ++j) { const f32x4 gg = gr[64 * j]; u32x2 w; w.x = pk2h(v[j].x * r * gg.x, v[j].y * r * gg.y); w.y = pk2h(v[j].z * r * gg.z, v[j].w * r * gg.w); o8[64 * j] = w; }
}
struct TItem { int idx, K, N; size_t dst; int map; };
__device__ __forceinline__ void prologue(const Ptrs& P, int gw, int NGW, int lane, float* scr) {
    unsigned char* ws = P.ws;
    constexpr int I_UP = 16 * 88, I_DN = 44 * 32, I_IN = 16 * 64, I_SQ = 16 * 32, I_PW = 8 * 4;
    constexpr int NITEMS = 4 * I_UP + 2 * I_DN + 2 * I_IN + 3 * I_SQ + I_PW;
    for (int it = gw; it < NITEMS; it += NGW) {
        int r = it;
        if (r < I_UP) { transpose_item(P.in[3], 1024, DFF, (u16*)(ws + WS_W1A), 1, scr, r, lane); continue; } r -= I_UP;
        if (r < I_UP) { transpose_item(P.in[4], 1024, DFF, (u16*)(ws + WS_W1A), 2, scr, r, lane); continue; } r -= I_UP;
        if (r < I_DN) { transpose_item(P.in[5], DFF, 1024, (u16*)(ws + WS_W1D), 0, scr, r, lane); continue; } r -= I_DN;
        if (r < I_UP) { transpose_item(P.in[20], 1024, DFF, (u16*)(ws + WS_W2A), 1, scr, r, lane); continue; } r -= I_UP;
        if (r < I_UP) { transpose_item(P.in[21], 1024, DFF, (u16*)(ws + WS_W2A), 2, scr, r, lane); continue; } r -= I_UP;
        if (r < I_DN) { transpose_item(P.in[22], DFF, 1024, (u16*)(ws + WS_W2D), 0, scr, r, lane); continue; } r -= I_DN;
        if (r < I_IN) { transpose_item(P.in[8], 1024, DIN, (u16*)(ws + WS_WIN), 0, scr, r, lane); continue; } r -= I_IN;
        if (r < I_IN) { transpose_item(P.in[16], 1024, 2048, (u16*)(ws + WS_WKV), 0, scr, r, lane); continue; } r -= I_IN;
        if (r < I_SQ) { transpose_item(P.in[11], 1024, 1024, (u16*)(ws + WS_WOUT), 0, scr, r, lane); continue; } r -= I_SQ;
        if (r < I_SQ) { transpose_item(P.in[15], 1024, 1024, (u16*)(ws + WS_WQ), 0, scr, r, lane); continue; } r -= I_SQ;
        if (r < I_SQ) { transpose_item(P.in[17], 1024, 1024, (u16*)(ws + WS_WO), 0, scr, r, lane); continue; } r -= I_SQ;
        transpose_item(P.in[9], 512, 128, (u16*)(ws + WS_WPT), 0, scr, r, lane);
    }
    for (int m = gw; m < M; m += NGW) rms_row_to_f16(P.in[0] + (size_t)m * DM, P.in[2], (u16*)(ws + WS_XN) + (size_t)m * DM, lane);
    for (int m = gw; m < BATCH * NMEM; m += NGW) rms_row_to_f16(P.in[1] + (size_t)m * DM, P.in[14], (u16*)(ws + WS_MEMN) + (size_t)m * DM, lane);
    float* km = (float*)(ws + WS_KMEAN);
    for (int i = gw * 64 + lane; i < BATCH * NBLK * 512; i += NGW * 64) km[i] = 0.f;
}
__global__ void __launch_bounds__(256) k_prologue(Ptrs P) {
    __shared__ float scr[4][64 * 33];
    const int wave = threadIdx.x >> 6, lane = threadIdx.x & 63;
    prologue(P, blockIdx.x * 4 + wave, gridDim.x * 4, lane, scr[wave]);
}

template <int MODE>
__global__ void __launch_bounds__(256) k_naive_gemm(const u16* A, int lda, const u16* Bt, int ldb, int K, void* C, int ldc, float sc, int sccols) {
    const int wave = threadIdx.x >> 6, lane = threadIdx.x & 63, r = lane & 31, h = lane >> 5;
    const int m0 = blockIdx.y * 64 + (wave >> 1) * 32;
    if (MODE == 2) {
        const int n0 = blockIdx.x * 64 + (wave & 1) * 32;
        const int rg = (n0 >> 7) * 256 + (n0 & 127), ru = rg + 128;
        f32x16 ag = {}, au = {};
        const u16* ap = A + (size_t)(m0 + r) * lda + 8 * h;
        const u16* bg = Bt + (size_t)(rg + r) * ldb + 8 * h;
        const u16* bu = Bt + (size_t)(ru + r) * ldb + 8 * h;
        for (int k = 0; k < K; k += 16) {
            const h8 a = *(const h8*)(ap + k), g = *(const h8*)(bg + k), u = *(const h8*)(bu + k);
            ag = __builtin_amdgcn_mfma_f32_32x32x16_f16(a, g, ag, 0, 0, 0);
            au = __builtin_amdgcn_mfma_f32_32x32x16_f16(a, u, au, 0, 0, 0);
        }
#pragma unroll
        for (int i = 0; i < 16; ++i) { const int row = m0 + (i & 3) + 8 * (i >> 2) + 4 * h, col = n0 + r;
            const float gv = ag[i], uv = au[i]; const float s = gv / (1.f + __expf(-gv));
            ((u16*)C)[(size_t)row * ldc + col] = f2h(s * uv); }
    } else {
        const int n0 = blockIdx.x * 64 + (wave & 1) * 32;
        f32x16 acc = {};
        const u16* ap = A + (size_t)(m0 + r) * lda + 8 * h;
        const u16* bp = Bt + (size_t)(n0 + r) * ldb + 8 * h;
        for (int k = 0; k < K; k += 16) {
            const h8 a = *(const h8*)(ap + k), b = *(const h8*)(bp + k);
            acc = __builtin_amdgcn_mfma_f32_32x32x16_f16(a, b, acc, 0, 0, 0);
        }
#pragma unroll
        for (int i = 0; i < 16; ++i) { const int row = m0 + (i & 3) + 8 * (i >> 2) + 4 * h, col = n0 + r;
            if (MODE == 0) ((u16*)C)[(size_t)row * ldc + col] = f2h(acc[i] * (col < sccols ? sc : 1.f));
            else ((float*)C)[(size_t)row * ldc + col] = acc[i]; }
    }
}
__global__ void __launch_bounds__(256) k_naive_rownorm(const float* F, const float* base, float w, const float* gpost, float* out, const float* gnext, u16* XN) {
    const int lane = threadIdx.x & 63, row = blockIdx.x * 4 + (threadIdx.x >> 6);
    const f32x4* fr = (const f32x4*)(F + (size_t)row * DM) + lane; const f32x4* br = (const f32x4*)(base + (size_t)row * DM) + lane;
    const f32x4* gp = (const f32x4*)gpost + lane;
    f32x4 f[4], x[4]; float s = 0.f;
#pragma unroll
    for (int j = 0; j < 4; ++j) { f[j] = fr[64 * j]; x[j] = br[64 * j]; s += (f[j].x * f[j].x + f[j].y * f[j].y) + (f[j].z * f[j].z + f[j].w * f[j].w); }
    const float r = 1.0f / sqrtf(wave_sum(s) * (1.f / DM) + EPS);
    float s2 = 0.f;
#pragma unroll
    for (int j = 0; j < 4; ++j) { const f32x4 g = gp[64 * j]; x[j] = x[j] + w * ((f[j] * r) * g); s2 += (x[j].x * x[j].x + x[j].y * x[j].y) + (x[j].z * x[j].z + x[j].w * x[j].w); }
    f32x4* orow = (f32x4*)(out + (size_t)row * DM) + lane;
#pragma unroll
    for (int j = 0; j < 4; ++j) orow[64 * j] = x[j];
    if (XN) {
        const float r2 = 1.0f / sqrtf(wave_sum(s2) * (1.f / DM) + EPS);
        const f32x4* gn = (const f32x4*)gnext + lane; u32x2* o8 = (u32x2*)(XN + (size_t)row * DM) + lane;
#pragma unroll
        for (int j = 0; j < 4; ++j) { const f32x4 g = gn[64 * j]; u32x2 o; o.x = pk2h(x[j].x * r2 * g.x, x[j].y * r2 * g.y); o.y = pk2h(x[j].z * r2 * g.z, x[j].w * r2 * g.w); o8[64 * j] = o; }
    }
}
__global__ void __launch_bounds__(256) k_naive_kmean(const u16* PROJ, float* KMEAN) {
    const int bb = blockIdx.x;
    for (int c = threadIdx.x; c < 512; c += 256) { float s = 0.f;
        for (int r = 0; r < LBLK; ++r) s += h2f(PROJ[(size_t)(bb * LBLK + r) * DIN + 512 + c]);
        KMEAN[(size_t)bb * 512 + c] = s * (1.f / LBLK); }
}
__global__ void __launch_bounds__(256) k_naive_moba(const u16* PROJ, const float* KMEAN, u16* MIX) {
    __shared__ float sq[4][64]; __shared__ float sp[4][1024];
    const int wave = threadIdx.x >> 6, lane = threadIdx.x & 63;
    const int gq = blockIdx.x * 4 + wave;
    const int t = gq % SEQ, h = (gq / SEQ) % NH, b = gq / (SEQ * NH);
    const size_t row = (size_t)b * SEQ + t;
    const int own = t / LBLK;
    const float qd = h2f(PROJ[row * DIN + h * HD + lane]);
    sq[wave][lane] = qd;
    float v1 = -INFINITY, v2 = -INFINITY, v3 = -INFINITY; int i1 = -1, i2 = -1, i3 = -1;
    for (int n = 0; n < own; ++n) {
        const float g = wave_sum(qd * KMEAN[((size_t)b * NBLK + n) * 512 + h * HD + lane]);
        if (g > v1) { v3 = v2; i3 = i2; v2 = v1; i2 = i1; v1 = g; i1 = n; }
        else if (g > v2) { v3 = v2; i3 = i2; v2 = g; i2 = n; }
        else if (g > v3) { v3 = g; i3 = n; }
    }
    const float slope2 = exp2f(-(float)(h + 1)) * LOG2E;
    int blks[4] = {i1, i2, i3, own};
    float s[16]; float mx = -INFINITY;
#pragma unroll
    for (int sl = 0; sl < 4; ++sl) {
        const int blk = blks[sl];
#pragma unroll
        for (int c = 0; c < 4; ++c) {
            float sc = -INFINITY;
            if (blk >= 0) {
                const int kpos = blk * LBLK + c * 64 + lane;
                if (kpos <= t) {
                    const u16* kr = PROJ + ((size_t)b * SEQ + kpos) * DIN + 512 + h * HD; float a = 0.f;
#pragma unroll 2
                    for (int d = 0; d < 64; d += 8) { const h8 kv = *(const h8*)(kr + d);
#pragma unroll
                        for (int j = 0; j < 8; ++j) a += sq[wave][d + j] * (float)kv[j]; }
                    sc = a - slope2 * (float)(t - kpos);
                }
            }
            s[sl * 4 + c] = sc; mx = fmaxf(mx, sc);
        }
    }
    mx = wave_max(mx);
    float l = 0.f;
#pragma unroll
    for (int i = 0; i < 16; ++i) { const float p = exp2f(s[i] - mx); l += p; sp[wave][i * 64 + lane] = p; }
    l = wave_sum(l);
    float o = 0.f;
#pragma unroll
    for (int sl = 0; sl < 4; ++sl) {
        const int blk = blks[sl];
        if (blk >= 0) {
            const u16* vb = PROJ + ((size_t)b * SEQ + blk * LBLK) * DIN + 1024 + h * HD + lane;
            for (int j = 0; j < LBLK; ++j) o += sp[wave][sl * 256 + j] * h2f(vb[(size_t)j * DIN]);
        }
    }
    MIX[row * DM + h * HD + lane] = f2h(o / l);
}
__global__ void __launch_bounds__(128) k_naive_pool(const u16* PROJ, const float* pool_w, const float* pool_scale, u16* MIX) {
    __shared__ float sd[128];
    const int g = blockIdx.x & 3; const size_t row = blockIdx.x >> 2; const int t = (int)(row % SEQ), c = threadIdx.x;
    const int w = 2 << g, lo = max(t + 1 - w, 0), cnt = t + 1 - lo;
    float s = 0.f;
    for (int j = lo; j <= t; ++j) s += h2f(PROJ[(row - (t - j)) * DIN + 1536 + g * 128 + c]);
    sd[c] = s / (float)cnt - h2f(PROJ[row * DIN + 1536 + g * 128 + c]);
    __syncthreads();
    float y = 0.f;
    for (int k = 0; k < 128; ++k) y += sd[k] * pool_w[((size_t)g * 128 + k) * 128 + c];
    MIX[row * DM + 512 + g * 128 + c] = f2h(y * pool_scale[g * 128 + c]);
}
__global__ void __launch_bounds__(256) k_naive_xattn(const u16* XQ, const u16* KMEM, const u16* VMEMT, u16* XAO) {
    __shared__ float sq[4][256]; __shared__ float sp[4][256];
    const int wave = threadIdx.x >> 6, lane = threadIdx.x & 63;
    const int gi = blockIdx.x * 4 + wave; const int h = gi & 3; const size_t row = gi >> 2; const int b = (int)(row / SEQ);
#pragma unroll
    for (int j = 0; j < 4; ++j) sq[wave][j * 64 + lane] = h2f(XQ[row * DM + h * XHD + j * 64 + lane]);
    float s[4]; float mx = -INFINITY;
#pragma unroll
    for (int j = 0; j < 4; ++j) { const int m = j * 64 + lane; const u16* kr = KMEM + ((size_t)b * NMEM + m) * DM + h * XHD; float a = 0.f;
#pragma unroll 2
        for (int d = 0; d < 256; d += 8) { const h8 kv = *(const h8*)(kr + d);
#pragma unroll
            for (int i = 0; i < 8; ++i) a += sq[wave][d + i] * (float)kv[i]; }
        s[j] = a; mx = fmaxf(mx, a); }
    mx = wave_max(mx); float l = 0.f;
#pragma unroll
    for (int j = 0; j < 4; ++j) { const float p = exp2f(s[j] - mx); l += p; sp[wave][j * 64 + lane] = p; }
    l = wave_sum(l);
#pragma unroll
    for (int j = 0; j < 4; ++j) { const int d = j * 64 + lane; const u16* vr = VMEMT + ((size_t)b * DM + h * XHD + d) * NMEM; float o = 0.f;
#pragma unroll 2
        for (int m = 0; m < 256; m += 8) { const h8 vv = *(const h8*)(vr + m);
#pragma unroll
            for (int i = 0; i < 8; ++i) o += sp[wave][m + i] * (float)vv[i]; }
        XAO[row * DM + h * XHD + d] = f2h(o / l); }
}

extern "C" void kernel_launch(void* const* d_in, const int* in_sizes, int n_in, void* d_out, int out_size, void* d_ws, size_t ws_size, hipStream_t stream) {
    if (n_in != 24 || out_size != M * DM || ws_size < WS_END) { fprintf(stderr, "kernel_launch: unexpected shapes (n_in %d out %d ws %zu)\n", n_in, out_size, ws_size); return; }
    Ptrs P{};
    for (int i = 0; i < 24; ++i) P.in[i] = (const float*)d_in[i];
    P.out = (float*)d_out; P.ws = (unsigned char*)d_ws;
    unsigned char* ws = (unsigned char*)d_ws;
    u16 *XN = (u16*)(ws + WS_XN), *ACT = (u16*)(ws + WS_ACT), *PROJ = (u16*)(ws + WS_PROJ), *MIX = (u16*)(ws + WS_MIX), *XQ = (u16*)(ws + WS_XQ), *XAO = (u16*)(ws + WS_XAO);
    u16 *MEMN = (u16*)(ws + WS_MEMN), *KMEM = (u16*)(ws + WS_KMEM), *VMEMT = (u16*)(ws + WS_VMEMT);
    float *F32A = (float*)(ws + WS_F32A), *F32B = (float*)(ws + WS_F32B), *KMEAN = (float*)(ws + WS_KMEAN), *OUT = (float*)d_out;
    (void)hipMemsetAsync(ws + WS_CTL, 0, CTL_BYTES, stream);
    k_prologue<<<1024, 256, 0, stream>>>(P);
    k_naive_gemm<2><<<dim3(DFF / 64, M / 64), 256, 0, stream>>>(XN, DM, (u16*)(ws + WS_W1A), DM, DM, ACT, DFF, 1.f, 0);
    k_naive_gemm<1><<<dim3(DM / 64, M / 64), 256, 0, stream>>>(ACT, DFF, (u16*)(ws + WS_W1D), DFF, DFF, F32A, DM, 1.f, 0);
    k_naive_rownorm<<<M / 4, 256, 0, stream>>>(F32A, P.in[0], 0.5f, P.in[6], OUT, P.in[7], XN);
    k_naive_gemm<0><<<dim3(DM / 64, BATCH * NMEM / 64), 256, 0, stream>>>(MEMN, DM, (u16*)(ws + WS_WKV), DM, DM, KMEM, DM, 1.f, 0);
    for (int b = 0; b < BATCH; ++b)
        k_naive_gemm<0><<<dim3(NMEM / 64, DM / 64), 256, 0, stream>>>((u16*)(ws + WS_WKV) + (size_t)DM * DM, DM, MEMN + (size_t)b * NMEM * DM, DM, DM, VMEMT + (size_t)b * DM * NMEM, NMEM, 1.f, 0);
    k_naive_gemm<0><<<dim3(DIN / 64, M / 64), 256, 0, stream>>>(XN, DM, (u16*)(ws + WS_WIN), DM, DM, PROJ, DIN, QSCALE, 512);
    k_naive_kmean<<<BATCH * NBLK, 256, 0, stream>>>(PROJ, KMEAN);
    k_naive_moba<<<BATCH * NH * SEQ / 4, 256, 0, stream>>>(PROJ, KMEAN, MIX);
    k_naive_pool<<<M * 4, 128, 0, stream>>>(PROJ, P.in[9], P.in[10], MIX);
    k_naive_gemm<1><<<dim3(DM / 64, M / 64), 256, 0, stream>>>(MIX, DM, (u16*)(ws + WS_WOUT), DM, DM, F32B, DM, 1.f, 0);
    k_naive_rownorm<<<M / 4, 256, 0, stream>>>(F32B, OUT, 1.0f, P.in[12], OUT, P.in[13], XN);
    k_naive_gemm<0><<<dim3(DM / 64, M / 64), 256, 0, stream>>>(XN, DM, (u16*)(ws + WS_WQ), DM, DM, XQ, DM, XQSCALE, DM);
    k_naive_xattn<<<M * XH / 4, 256, 0, stream>>>(XQ, KMEM, VMEMT, XAO);
    k_naive_gemm<1><<<dim3(DM / 64, M / 64), 256, 0, stream>>>(XAO, DM, (u16*)(ws + WS_WO), DM, DM, F32B, DM, 1.f, 0);
    k_naive_rownorm<<<M / 4, 256, 0, stream>>>(F32B, OUT, 1.0f, P.in[18], OUT, P.in[19], XN);
    k_naive_gemm<2><<<dim3(DFF / 64, M / 64), 256, 0, stream>>>(XN, DM, (u16*)(ws + WS_W2A), DM, DM, ACT, DFF, 1.f, 0);
    k_naive_gemm<1><<<dim3(DM / 64, M / 64), 256, 0, stream>>>(ACT, DFF, (u16*)(ws + WS_W2D), DFF, DFF, F32A, DM, 1.f, 0);
    k_naive_rownorm<<<M / 4, 256, 0, stream>>>(F32A, OUT, 0.5f, P.in[23], OUT, nullptr, nullptr);
}
```

```cpp
#include <hip/hip_runtime.h>
#include <hip/hip_cooperative_groups.h>
#include <cstdio>
#include <cstdint>

typedef unsigned short u16;
typedef _Float16 h8 __attribute__((ext_vector_type(8)));
typedef _Float16 h2 __attribute__((ext_vector_type(2)));
typedef float f32x2 __attribute__((ext_vector_type(2)));
typedef float f32x4 __attribute__((ext_vector_type(4)));
typedef float f32x16 __attribute__((ext_vector_type(16)));
typedef unsigned u32x4 __attribute__((ext_vector_type(4)));
typedef unsigned u32x2 __attribute__((ext_vector_type(2)));

constexpr int BATCH = 4, SEQ = 4096, DM = 1024, M = BATCH * SEQ;
constexpr int NH = 8, HD = 64, DATT = 512, DPOOL = 512, DIN = 2048;
constexpr int LBLK = 256, NBLK = SEQ / LBLK;
constexpr int NMEM = 256, XH = 4, XHD = 256;
constexpr int DFF = 2816;
constexpr float EPS = 1e-6f;
constexpr float LOG2E = 1.4426950408889634f;
constexpr float QSCALE = 0.125f * LOG2E;
constexpr float XQSCALE = 0.0625f * LOG2E;

constexpr size_t MiB = 1u << 20;
constexpr size_t WS_CTL = 0, CTL_BYTES = 1 * MiB;
constexpr size_t WS_KMEAN = 1 * MiB;
constexpr size_t WS_XBUF = 2 * MiB;
constexpr size_t WS_MEMN = 5 * MiB;
constexpr size_t WS_KMEM = 7 * MiB;
constexpr size_t WS_VMEMT = 9 * MiB;
constexpr size_t WS_WPT = 11 * MiB;
constexpr size_t WS_W1A = 12 * MiB;
constexpr size_t WS_W1D = 23 * MiB;
constexpr size_t WS_W2A = WS_W1D + 5 * MiB + MiB / 2;
constexpr size_t WS_W2D = WS_W2A + 11 * MiB;
constexpr size_t WS_WIN = 45 * MiB;
constexpr size_t WS_WOUT = 49 * MiB;
constexpr size_t WS_WQ = 51 * MiB;
constexpr size_t WS_WKV = 53 * MiB;
constexpr size_t WS_WO = 57 * MiB;
constexpr size_t WS_XN = 60 * MiB;
constexpr size_t WS_R1 = 92 * MiB;
constexpr size_t WS_ACT = WS_R1, WS_PROJ = WS_R1, WS_XQ = WS_R1, WS_XP = WS_R1 + 32 * MiB, WS_F32B = WS_R1;
constexpr size_t WS_R2 = 180 * MiB;
constexpr size_t WS_MIX = WS_R2, WS_XAO = WS_R2 + 32 * MiB, WS_F32A = WS_R2;
constexpr size_t WS_END = 244 * MiB;

__device__ __forceinline__ float h2f(u16 v) { return (float)__builtin_bit_cast(_Float16, v); }
__device__ __forceinline__ u16 f2h(float f) { return __builtin_bit_cast(u16, (_Float16)f); }
__device__ __forceinline__ unsigned pk2h(float lo, float hi) { f32x2 v = {lo, hi}; h2 h = __builtin_convertvector(v, h2); return __builtin_bit_cast(unsigned, h); }
__device__ __forceinline__ float wave_sum(float v) {
#pragma unroll
    for (int o = 1; o < 64; o <<= 1) v += __shfl_xor(v, o);
    return v;
}
__device__ __forceinline__ float wave_max(float v) {
#pragma unroll
    for (int o = 1; o < 64; o <<= 1) v = fmaxf(v, __shfl_xor(v, o));
    return v;
}

struct Ptrs {
    const float* in[24];
    float* out;
    unsigned char* ws;
};

__device__ __forceinline__ int rowmap(int map, int n) { return map == 0 ? n : ((n >> 7) * 256 + (map == 2 ? 128 : 0) + (n & 127)); }
__device__ __forceinline__ void transpose_item(const float* W, int K, int N, u16* WT, int map, float* scr, int item, int lane) {
    const int nblk = N / 32, kb = item / nblk, nb = item % nblk, k0 = 64 * kb, n0 = 32 * nb;
#pragma unroll 8
    for (int i = 0; i < 32; ++i) { const int kk = 2 * i + (lane >> 5); scr[kk * 33 + (lane & 31)] = W[(size_t)(k0 + kk) * N + n0 + (lane & 31)]; }
    asm volatile("s_waitcnt lgkmcnt(0)" ::: "memory");
    const int c = lane & 7;
    const int r0 = rowmap(map, n0);
#pragma unroll
    for (int j = 0; j < 4; ++j) { const int n = (lane >> 3) + 8 * j; const float* s = scr + (8 * c) * 33 + n;
        u32x4 o; o.x = pk2h(s[0 * 33], s[1 * 33]); o.y = pk2h(s[2 * 33], s[3 * 33]); o.z = pk2h(s[4 * 33], s[5 * 33]); o.w = pk2h(s[6 * 33], s[7 * 33]);
        *(u32x4*)(WT + (size_t)(r0 + n) * K + k0 + 8 * c) = o; }
    asm volatile("s_waitcnt lgkmcnt(0)" ::: "memory");
}
__device__ __forceinline__ void rms_row_to_f16(const float* xrow, const float* g, u16* orow, int lane) {
    const f32x4* xr = (const f32x4*)xrow + lane; const f32x4* gr = (const f32x4*)g + lane;
    f32x4 v[4]; float s = 0.f;
#pragma unroll
    for (int j = 0; j < 4; ++j) { v[j] = xr[64 * j]; s += (v[j].x * v[j].x + v[j].y * v[j].y) + (v[j].z * v[j].z + v[j].w * v[j].w); }
    const float r = 1.0f / sqrtf(wave_sum(s) * (1.f / DM) + EPS);
    u32x2* o8 = (u32x2*)orow + lane;
#pragma unroll
    for (int j = 0; j < 4; ++j) { const f32x4 gg = gr[64 * j]; u32x2 w; w.x = pk2h(v[j].x * r * gg.x, v[j].y * r * gg.y); w.y = pk2h(v[j].z * r * gg.z, v[j].w * r * gg.w); o8[64 * j] = w; }
}
struct TItem { int idx, K, N; size_t dst; int map; };
__device__ __forceinline__ void prologue(const Ptrs& P, int gw, int NGW, int lane, float* scr) {
    unsigned char* ws = P.ws;
    constexpr int I_UP = 16 * 88, I_DN = 44 * 32, I_IN = 16 * 64, I_SQ = 16 * 32, I_PW = 8 * 4;
    constexpr int NITEMS = 4 * I_UP + 2 * I_DN + 2 * I_IN + 3 * I_SQ + I_PW;
    for (int it = gw; it < NITEMS; it += NGW) {
        int r = it;
        if (r < I_UP) { transpose_item(P.in[3], 1024, DFF, (u16*)(ws + WS_W1A), 1, scr, r, lane); continue; } r -= I_UP;
        if (r < I_UP) { transpose_item(P.in[4], 1024, DFF, (u16*)(ws + WS_W1A), 2, scr, r, lane); continue; } r -= I_UP;
        if (r < I_DN) { transpose_item(P.in[5], DFF, 1024, (u16*)(ws + WS_W1D), 0, scr, r, lane); continue; } r -= I_DN;
        if (r < I_UP) { transpose_item(P.in[20], 1024, DFF, (u16*)(ws + WS_W2A), 1, scr, r, lane); continue; } r -= I_UP;
        if (r < I_UP) { transpose_item(P.in[21], 1024, DFF, (u16*)(ws + WS_W2A), 2, scr, r, lane); continue; } r -= I_UP;
        if (r < I_DN) { transpose_item(P.in[22], DFF, 1024, (u16*)(ws + WS_W2D), 0, scr, r, lane); continue; } r -= I_DN;
        if (r < I_IN) { transpose_item(P.in[8], 1024, DIN, (u16*)(ws + WS_WIN), 0, scr, r, lane); continue; } r -= I_IN;
        if (r < I_IN) { transpose_item(P.in[16], 1024, 2048, (u16*)(ws + WS_WKV), 0, scr, r, lane); continue; } r -= I_IN;
        if (r < I_SQ) { transpose_item(P.in[11], 1024, 1024, (u16*)(ws + WS_WOUT), 0, scr, r, lane); continue; } r -= I_SQ;
        if (r < I_SQ) { transpose_item(P.in[15], 1024, 1024, (u16*)(ws + WS_WQ), 0, scr, r, lane); continue; } r -= I_SQ;
        if (r < I_SQ) { transpose_item(P.in[17], 1024, 1024, (u16*)(ws + WS_WO), 0, scr, r, lane); continue; } r -= I_SQ;
        transpose_item(P.in[9], 512, 128, (u16*)(ws + WS_WPT), 0, scr, r, lane);
    }
    for (int m = gw; m < M; m += NGW) rms_row_to_f16(P.in[0] + (size_t)m * DM, P.in[2], (u16*)(ws + WS_XN) + (size_t)m * DM, lane);
    for (int m = gw; m < BATCH * NMEM; m += NGW) rms_row_to_f16(P.in[1] + (size_t)m * DM, P.in[14], (u16*)(ws + WS_MEMN) + (size_t)m * DM, lane);
    float* km = (float*)(ws + WS_KMEAN);
    for (int i = gw * 64 + lane; i < BATCH * NBLK * 512; i += NGW * 64) km[i] = 0.f;
}

template <int MODE>
__device__ __forceinline__ void nv_gemm(int gw, int NGW, int lane, const u16* A, int lda, const u16* Bt, int ldb, int Mr, int N, int K, void* C, int ldc, float sc, int sccols) {
    const int r = lane & 31, h = lane >> 5, ntn = N / 32, ntiles = (Mr / 32) * ntn;
    for (int wt = gw; wt < ntiles; wt += NGW) {
        const int m0 = (wt / ntn) * 32, n0 = (wt % ntn) * 32;
        const u16* ap = A + (size_t)(m0 + r) * lda + 8 * h;
        if (MODE == 2) {
            const int rg = (n0 >> 7) * 256 + (n0 & 127), ru = rg + 128;
            f32x16 ag = {}, au = {};
            const u16* bg = Bt + (size_t)(rg + r) * ldb + 8 * h;
            const u16* bu = Bt + (size_t)(ru + r) * ldb + 8 * h;
            for (int k = 0; k < K; k += 16) {
                const h8 a = *(const h8*)(ap + k), g = *(const h8*)(bg + k), u = *(const h8*)(bu + k);
                ag = __builtin_amdgcn_mfma_f32_32x32x16_f16(a, g, ag, 0, 0, 0);
                au = __builtin_amdgcn_mfma_f32_32x32x16_f16(a, u, au, 0, 0, 0);
            }
#pragma unroll
            for (int i = 0; i < 16; ++i) { const int row = m0 + (i & 3) + 8 * (i >> 2) + 4 * h, col = n0 + r;
                const float gv = ag[i], uv = au[i]; const float sg = gv / (1.f + __expf(-gv));
                ((u16*)C)[(size_t)row * ldc + col] = f2h(sg * uv); }
        } else {
            f32x16 acc = {};
            const u16* bp = Bt + (size_t)(n0 + r) * ldb + 8 * h;
            for (int k = 0; k < K; k += 16) {
                const h8 a = *(const h8*)(ap + k), b = *(const h8*)(bp + k);
                acc = __builtin_amdgcn_mfma_f32_32x32x16_f16(a, b, acc, 0, 0, 0);
            }
#pragma unroll
            for (int i = 0; i < 16; ++i) { const int row = m0 + (i & 3) + 8 * (i >> 2) + 4 * h, col = n0 + r;
                if (MODE == 0) ((u16*)C)[(size_t)row * ldc + col] = f2h(acc[i] * (col < sccols ? sc : 1.f));
                else ((float*)C)[(size_t)row * ldc + col] = acc[i]; }
        }
    }
}
__device__ __forceinline__ void nv_rownorm(int gw, int NGW, int lane, const float* F, const float* base, float w, const float* gpost, float* out, const float* gnext, u16* XN) {
    for (int row = gw; row < M; row += NGW) {
        const f32x4* fr = (const f32x4*)(F + (size_t)row * DM) + lane; const f32x4* br = (const f32x4*)(base + (size_t)row * DM) + lane;
        const f32x4* gp = (const f32x4*)gpost + lane;
        f32x4 f[4], x[4]; float s = 0.f;
#pragma unroll
        for (int j = 0; j < 4; ++j) { f[j] = fr[64 * j]; x[j] = br[64 * j]; s += (f[j].x * f[j].x + f[j].y * f[j].y) + (f[j].z * f[j].z + f[j].w * f[j].w); }
        const float r = 1.0f / sqrtf(wave_sum(s) * (1.f / DM) + EPS);
        float s2 = 0.f;
#pragma unroll
        for (int j = 0; j < 4; ++j) { const f32x4 g = gp[64 * j]; x[j] = x[j] + w * ((f[j] * r) * g); s2 += (x[j].x * x[j].x + x[j].y * x[j].y) + (x[j].z * x[j].z + x[j].w * x[j].w); }
        f32x4* orow = (f32x4*)(out + (size_t)row * DM) + lane;
#pragma unroll
        for (int j = 0; j < 4; ++j) orow[64 * j] = x[j];
        if (XN) {
            const float r2 = 1.0f / sqrtf(wave_sum(s2) * (1.f / DM) + EPS);
            const f32x4* gn = (const f32x4*)gnext + lane; u32x2* o8 = (u32x2*)(XN + (size_t)row * DM) + lane;
#pragma unroll
            for (int j = 0; j < 4; ++j) { const f32x4 g = gn[64 * j]; u32x2 o; o.x = pk2h(x[j].x * r2 * g.x, x[j].y * r2 * g.y); o.y = pk2h(x[j].z * r2 * g.z, x[j].w * r2 * g.w); o8[64 * j] = o; }
        }
    }
}
__device__ __forceinline__ void nv_kmean(int gw, int NGW, int lane, const u16* PROJ, float* KMEAN) {
    for (int i = gw * 64 + lane; i < BATCH * NBLK * 512; i += NGW * 64) { const int bb = i >> 9, c = i & 511; float s = 0.f;
        for (int r = 0; r < LBLK; ++r) s += h2f(PROJ[(size_t)(bb * LBLK + r) * DIN + 512 + c]);
        KMEAN[i] = s * (1.f / LBLK); }
}
__device__ __forceinline__ void nv_moba(int gw, int NGW, int lane, float* wl, const u16* PROJ, const float* KMEAN, u16* MIX) {
    float* sq = wl; float* sp = wl + 64;
    for (int gq = gw; gq < BATCH * NH * SEQ; gq += NGW) {
        const int t = gq % SEQ, h = (gq / SEQ) % NH, b = gq / (SEQ * NH);
        const size_t row = (size_t)b * SEQ + t;
        const int own = t / LBLK;
        const float qd = h2f(PROJ[row * DIN + h * HD + lane]);
        sq[lane] = qd;
        float v1 = -INFINITY, v2 = -INFINITY, v3 = -INFINITY; int i1 = -1, i2 = -1, i3 = -1;
        for (int n = 0; n < own; ++n) {
            const float g = wave_sum(qd * KMEAN[((size_t)b * NBLK + n) * 512 + h * HD + lane]);
            if (g > v1) { v3 = v2; i3 = i2; v2 = v1; i2 = i1; v1 = g; i1 = n; }
            else if (g > v2) { v3 = v2; i3 = i2; v2 = g; i2 = n; }
            else if (g > v3) { v3 = g; i3 = n; }
        }
        const float slope2 = exp2f(-(float)(h + 1)) * LOG2E;
        int blks[4] = {i1, i2, i3, own};
        float s[16]; float mx = -INFINITY;
#pragma unroll
        for (int sl = 0; sl < 4; ++sl) {
            const int blk = blks[sl];
#pragma unroll
            for (int c = 0; c < 4; ++c) {
                float sc = -INFINITY;
                if (blk >= 0) {
                    const int kpos = blk * LBLK + c * 64 + lane;
                    if (kpos <= t) {
                        const u16* kr = PROJ + ((size_t)b * SEQ + kpos) * DIN + 512 + h * HD; float a = 0.f;
#pragma unroll 2
                        for (int d = 0; d < 64; d += 8) { const h8 kv = *(const h8*)(kr + d);
#pragma unroll
                            for (int j = 0; j < 8; ++j) a += sq[d + j] * (float)kv[j]; }
                        sc = a - slope2 * (float)(t - kpos);
                    }
                }
                s[sl * 4 + c] = sc; mx = fmaxf(mx, sc);
            }
        }
        mx = wave_max(mx);
        float l = 0.f;
#pragma unroll
        for (int i = 0; i < 16; ++i) { const float p = exp2f(s[i] - mx); l += p; sp[i * 64 + lane] = p; }
        l = wave_sum(l);
        float o = 0.f;
#pragma unroll
        for (int sl = 0; sl < 4; ++sl) {
            const int blk = blks[sl];
            if (blk >= 0) {
                const u16* vb = PROJ + ((size_t)b * SEQ + blk * LBLK) * DIN + 1024 + h * HD + lane;
                for (int j = 0; j < LBLK; ++j) o += sp[sl * 256 + j] * h2f(vb[(size_t)j * DIN]);
            }
        }
        MIX[row * DM + h * HD + lane] = f2h(o / l);
    }
}
__device__ __forceinline__ void nv_pool(int gw, int NGW, int lane, float* wl, const u16* PROJ, const float* pool_w, const float* pool_scale, u16* MIX) {
    for (int it = gw; it < M * 4; it += NGW) {
        const int g = it & 3; const size_t row = it >> 2; const int t = (int)(row % SEQ);
        const int w = 2 << g, lo = max(t + 1 - w, 0), cnt = t + 1 - lo;
#pragma unroll
        for (int hh = 0; hh < 2; ++hh) { const int c = lane + 64 * hh; float s = 0.f;
            for (int j = lo; j <= t; ++j) s += h2f(PROJ[(row - (t - j)) * DIN + 1536 + g * 128 + c]);
            wl[c] = s / (float)cnt - h2f(PROJ[row * DIN + 1536 + g * 128 + c]); }
        float y0 = 0.f, y1 = 0.f;
        for (int k = 0; k < 128; ++k) { const float d = wl[k]; y0 += d * pool_w[((size_t)g * 128 + k) * 128 + lane]; y1 += d * pool_w[((size_t)g * 128 + k) * 128 + lane + 64]; }
        MIX[row * DM + 512 + g * 128 + lane] = f2h(y0 * pool_scale[g * 128 + lane]);
        MIX[row * DM + 512 + g * 128 + lane + 64] = f2h(y1 * pool_scale[g * 128 + lane + 64]);
    }
}
__device__ __forceinline__ void nv_xattn(int gw, int NGW, int lane, float* wl, const u16* XQ, const u16* KMEM, const u16* VMEMT, u16* XAO) {
    float* sq = wl; float* sp = wl + 256;
    for (int gi = gw; gi < M * XH; gi += NGW) {
        const int h = gi & 3; const size_t row = gi >> 2; const int b = (int)(row / SEQ);
#pragma unroll
        for (int j = 0; j < 4; ++j) sq[j * 64 + lane] = h2f(XQ[row * DM + h * XHD + j * 64 + lane]);
        float s[4]; float mx = -INFINITY;
#pragma unroll
        for (int j = 0; j < 4; ++j) { const int m = j * 64 + lane; const u16* kr = KMEM + ((size_t)b * NMEM + m) * DM + h * XHD; float a = 0.f;
#pragma unroll 2
            for (int d = 0; d < 256; d += 8) { const h8 kv = *(const h8*)(kr + d);
#pragma unroll
                for (int i = 0; i < 8; ++i) a += sq[d + i] * (float)kv[i]; }
            s[j] = a; mx = fmaxf(mx, a); }
        mx = wave_max(mx); float l = 0.f;
#pragma unroll
        for (int j = 0; j < 4; ++j) { const float p = exp2f(s[j] - mx); l += p; sp[j * 64 + lane] = p; }
        l = wave_sum(l);
#pragma unroll
        for (int j = 0; j < 4; ++j) { const int d = j * 64 + lane; const u16* vr = VMEMT + ((size_t)b * DM + h * XHD + d) * NMEM; float o = 0.f;
#pragma unroll 2
            for (int m = 0; m < 256; m += 8) { const h8 vv = *(const h8*)(vr + m);
#pragma unroll
                for (int i = 0; i < 8; ++i) o += sp[m + i] * (float)vv[i]; }
            XAO[row * DM + h * XHD + d] = f2h(o / l); }
    }
}

namespace cg = cooperative_groups;
constexpr int NWAVES = 8, NTHREADS = NWAVES * 64;
constexpr int LDS_BYTES = 147456;
struct Args { Ptrs p; };

__global__ void __launch_bounds__(NTHREADS, 2) mega(Args args) {
    extern __shared__ __attribute__((aligned(16))) unsigned char lds[];
    cg::grid_group grid = cg::this_grid();
    const Ptrs& P = args.p;
    unsigned char* ws = P.ws;
    const int tid = threadIdx.x, lane = tid & 63, wave = __builtin_amdgcn_readfirstlane(tid >> 6);
    const int G = gridDim.x, gw = blockIdx.x * NWAVES + wave, NGW = G * NWAVES;
    float* wl = (float*)(lds + wave * 16384);
    u16 *XN = (u16*)(ws + WS_XN), *ACT = (u16*)(ws + WS_ACT), *PROJ = (u16*)(ws + WS_PROJ), *MIX = (u16*)(ws + WS_MIX), *XQ = (u16*)(ws + WS_XQ), *XAO = (u16*)(ws + WS_XAO);
    u16 *MEMN = (u16*)(ws + WS_MEMN), *KMEM = (u16*)(ws + WS_KMEM), *VMEMT = (u16*)(ws + WS_VMEMT);
    float *F32A = (float*)(ws + WS_F32A), *F32B = (float*)(ws + WS_F32B), *KMEAN = (float*)(ws + WS_KMEAN), *OUT = P.out;
#define GSYNC() grid.sync()
    prologue(P, gw, NGW, lane, wl);
    GSYNC();
    nv_gemm<2>(gw, NGW, lane, XN, DM, (u16*)(ws + WS_W1A), DM, M, DFF, DM, ACT, DFF, 1.f, 0);
    nv_gemm<0>(gw, NGW, lane, MEMN, DM, (u16*)(ws + WS_WKV), DM, BATCH * NMEM, DM, DM, KMEM, DM, 1.f, 0);
    for (int b = 0; b < BATCH; ++b)
        nv_gemm<0>(gw, NGW, lane, (u16*)(ws + WS_WKV) + (size_t)DM * DM, DM, MEMN + (size_t)b * NMEM * DM, DM, DM, NMEM, DM, VMEMT + (size_t)b * DM * NMEM, NMEM, 1.f, 0);
    GSYNC();
    nv_gemm<1>(gw, NGW, lane, ACT, DFF, (u16*)(ws + WS_W1D), DFF, M, DM, DFF, F32A, DM, 1.f, 0);
    GSYNC();
    nv_rownorm(gw, NGW, lane, F32A, P.in[0], 0.5f, P.in[6], OUT, P.in[7], XN);
    GSYNC();
    nv_gemm<0>(gw, NGW, lane, XN, DM, (u16*)(ws + WS_WIN), DM, M, DIN, DM, PROJ, DIN, QSCALE, 512);
    GSYNC();
    nv_kmean(gw, NGW, lane, PROJ, KMEAN);
    GSYNC();
    nv_moba(gw, NGW, lane, wl, PROJ, KMEAN, MIX);
    nv_pool(gw, NGW, lane, wl, PROJ, P.in[9], P.in[10], MIX);
    GSYNC();
    nv_gemm<1>(gw, NGW, lane, MIX, DM, (u16*)(ws + WS_WOUT), DM, M, DM, DM, F32B, DM, 1.f, 0);
    GSYNC();
    nv_rownorm(gw, NGW, lane, F32B, OUT, 1.0f, P.in[12], OUT, P.in[13], XN);
    GSYNC();
    nv_gemm<0>(gw, NGW, lane, XN, DM, (u16*)(ws + WS_WQ), DM, M, DM, DM, XQ, DM, XQSCALE, DM);
    GSYNC();
    nv_xattn(gw, NGW, lane, wl, XQ, KMEM, VMEMT, XAO);
    GSYNC();
    nv_gemm<1>(gw, NGW, lane, XAO, DM, (u16*)(ws + WS_WO), DM, M, DM, DM, F32B, DM, 1.f, 0);
    GSYNC();
    nv_rownorm(gw, NGW, lane, F32B, OUT, 1.0f, P.in[18], OUT, P.in[19], XN);
    GSYNC();
    nv_gemm<2>(gw, NGW, lane, XN, DM, (u16*)(ws + WS_W2A), DM, M, DFF, DM, ACT, DFF, 1.f, 0);
    GSYNC();
    nv_gemm<1>(gw, NGW, lane, ACT, DFF, (u16*)(ws + WS_W2D), DFF, M, DM, DFF, F32A, DM, 1.f, 0);
    GSYNC();
    nv_rownorm(gw, NGW, lane, F32A, OUT, 0.5f, P.in[23], OUT, nullptr, nullptr);
}

extern "C" void kernel_launch(void* const* d_in, const int* in_sizes, int n_in, void* d_out, int out_size, void* d_ws, size_t ws_size, hipStream_t stream) {
    static int grid = 0;
    if (grid == 0) {
        if (n_in != 24 || out_size != M * DM || ws_size < WS_END) { fprintf(stderr, "kernel_launch: unexpected shapes (n_in %d out %d ws %zu)\n", n_in, out_size, ws_size); grid = -1; return; }
        int dev = 0, cus = 0, per_cu = 0;
        if (hipGetDevice(&dev) != hipSuccess || hipDeviceGetAttribute(&cus, hipDeviceAttributeMultiprocessorCount, dev) != hipSuccess) { grid = -1; return; }
        if (hipFuncSetAttribute((const void*)mega, hipFuncAttributeMaxDynamicSharedMemorySize, LDS_BYTES) != hipSuccess) { fprintf(stderr, "kernel_launch: hipFuncSetAttribute failed\n"); grid = -1; return; }
        if (hipOccupancyMaxActiveBlocksPerMultiprocessor(&per_cu, (const void*)mega, NTHREADS, LDS_BYTES) != hipSuccess || per_cu < 1) { fprintf(stderr, "kernel_launch: occupancy query failed (%d)\n", per_cu); grid = -1; return; }
        grid = cus * 1;
        fprintf(stderr, "kernel_launch: %d CUs, occupancy %d/CU, grid %d\n", cus, per_cu, grid);
    }
    if (grid < 0) return;
    (void)hipMemsetAsync((unsigned char*)d_ws + WS_CTL, 0, CTL_BYTES, stream);
    Args a{};
    for (int i = 0; i < 24; ++i) a.p.in[i] = (const float*)d_in[i];
    a.p.out = (float*)d_out; a.p.ws = (unsigned char*)d_ws;
    void* kargs[] = {&a};
    hipError_t e = hipLaunchCooperativeKernel((const void*)mega, dim3(grid), dim3(NTHREADS), kargs, LDS_BYTES, stream);
    if (e != hipSuccess) fprintf(stderr, "kernel_launch: cooperative launch failed: %s (grid %d)\n", hipGetErrorString(e), grid);
}
```

```cpp
#include <hip/hip_runtime.h>
#include <hip/hip_cooperative_groups.h>
#include <cstdio>
#include <cstdint>

typedef unsigned short u16;
typedef _Float16 h8 __attribute__((ext_vector_type(8)));
typedef _Float16 h2 __attribute__((ext_vector_type(2)));
typedef float f32x2 __attribute__((ext_vector_type(2)));
typedef float f32x4 __attribute__((ext_vector_type(4)));
typedef float f32x16 __attribute__((ext_vector_type(16)));
typedef unsigned u32x4 __attribute__((ext_vector_type(4)));
typedef unsigned u32x2 __attribute__((ext_vector_type(2)));

constexpr int BATCH = 4, SEQ = 4096, DM = 1024, M = BATCH * SEQ;
constexpr int NH = 8, HD = 64, DATT = 512, DPOOL = 512, DIN = 2048;
constexpr int LBLK = 256, NBLK = SEQ / LBLK;
constexpr int NMEM = 256, XH = 4, XHD = 256;
constexpr int DFF = 2816;
constexpr float EPS = 1e-6f;
constexpr float LOG2E = 1.4426950408889634f;
constexpr float QSCALE = 0.125f * LOG2E;
constexpr float XQSCALE = 0.0625f * LOG2E;

constexpr size_t MiB = 1u << 20;
constexpr size_t WS_CTL = 0, CTL_BYTES = 1 * MiB;
constexpr size_t WS_KMEAN = 1 * MiB;
constexpr size_t WS_XBUF = 2 * MiB;
constexpr size_t WS_MEMN = 5 * MiB;
constexpr size_t WS_KMEM = 7 * MiB;
constexpr size_t WS_VMEMT = 9 * MiB;
constexpr size_t WS_WPT = 11 * MiB;
constexpr size_t WS_W1A = 12 * MiB;
constexpr size_t WS_W1D = 23 * MiB;
constexpr size_t WS_W2A = WS_W1D + 5 * MiB + MiB / 2;
constexpr size_t WS_W2D = WS_W2A + 11 * MiB;
constexpr size_t WS_WIN = 45 * MiB;
constexpr size_t WS_WOUT = 49 * MiB;
constexpr size_t WS_WQ = 51 * MiB;
constexpr size_t WS_WKV = 53 * MiB;
constexpr size_t WS_WO = 57 * MiB;
constexpr size_t WS_XN = 60 * MiB;
constexpr size_t WS_R1 = 92 * MiB;
constexpr size_t WS_ACT = WS_R1, WS_PROJ = WS_R1, WS_XQ = WS_R1, WS_XP = WS_R1 + 32 * MiB, WS_F32B = WS_R1;
constexpr size_t WS_R2 = 180 * MiB;
constexpr size_t WS_MIX = WS_R2, WS_XAO = WS_R2 + 32 * MiB, WS_F32A = WS_R2;
constexpr size_t WS_END = 244 * MiB;

__device__ __forceinline__ float h2f(u16 v) { return (float)__builtin_bit_cast(_Float16, v); }
__device__ __forceinline__ u16 f2h(float f) { return __builtin_bit_cast(u16, (_Float16)f); }
__device__ __forceinline__ unsigned pk2h(float lo, float hi) { f32x2 v = {lo, hi}; h2 h = __builtin_convertvector(v, h2); return __builtin_bit_cast(unsigned, h); }
__device__ __forceinline__ float wave_sum(float v) {
#pragma unroll
    for (int o = 1; o < 64; o <<= 1) v += __shfl_xor(v, o);
    return v;
}
__device__ __forceinline__ float wave_max(float v) {
#pragma unroll
    for (int o = 1; o < 64; o <<= 1) v = fmaxf(v, __shfl_xor(v, o));
    return v;
}

struct Ptrs {
    const float* in[24];
    float* out;
    unsigned char* ws;
};

__device__ __forceinline__ int rowmap(int map, int n) { return map == 0 ? n : ((n >> 7) * 256 + (map == 2 ? 128 : 0) + (n & 127)); }
__device__ __forceinline__ void transpose_item(const float* W, int K, int N, u16* WT, int map, float* scr, int item, int lane) {
    const int nblk = N / 32, kb = item / nblk, nb = item % nblk, k0 = 64 * kb, n0 = 32 * nb;
#pragma unroll 8
    for (int i = 0; i < 32; ++i) { const int kk = 2 * i + (lane >> 5); scr[kk * 33 + (lane & 31)] = W[(size_t)(k0 + kk) * N + n0 + (lane & 31)]; }
    asm volatile("s_waitcnt lgkmcnt(0)" ::: "memory");
    const int c = lane & 7;
    const int r0 = rowmap(map, n0);
#pragma unroll
    for (int j = 0; j < 4; ++j) { const int n = (lane >> 3) + 8 * j; const float* s = scr + (8 * c) * 33 + n;
        u32x4 o; o.x = pk2h(s[0 * 33], s[1 * 33]); o.y = pk2h(s[2 * 33], s[3 * 33]); o.z = pk2h(s[4 * 33], s[5 * 33]); o.w = pk2h(s[6 * 33], s[7 * 33]);
        *(u32x4*)(WT + (size_t)(r0 + n) * K + k0 + 8 * c) = o; }
    asm volatile("s_waitcnt lgkmcnt(0)" ::: "memory");
}
__device__ __forceinline__ void rms_row_to_f16(const float* xrow, const float* g, u16* orow, int lane) {
    const f32x4* xr = (const f32x4*)xrow + lane; const f32x4* gr = (const f32x4*)g + lane;
    f32x4 v[4]; float s = 0.f;
#pragma unroll
    for (int j = 0; j < 4; ++j) { v[j] = xr[64 * j]; s += (v[j].x * v[j].x + v[j].y * v[j].y) + (v[j].z * v[j].z + v[j].w * v[j].w); }
    const float r = 1.0f / sqrtf(wave_sum(s) * (1.f / DM) + EPS);
    u32x2* o8 = (u32x2*)orow + lane;
#pragma unroll
    for (int j = 0; j < 4; ++j) { const f32x4 gg = gr[64 * j]; u32x2 w; w.x = pk2h(v[j].x * r * gg.x, v[j].y * r * gg.y); w.y = pk2h(v[j].z * r * gg.z, v[j].w * r * gg.w); o8[64 * j] = w; }
}
struct TItem { int idx, K, N; size_t dst; int map; };
__device__ __forceinline__ void prologue(const Ptrs& P, int gw, int NGW, int lane, float* scr) {
    unsigned char* ws = P.ws;
    constexpr int I_UP = 16 * 88, I_DN = 44 * 32, I_IN = 16 * 64, I_SQ = 16 * 32, I_PW = 8 * 4;
    constexpr int NITEMS = 4 * I_UP + 2 * I_DN + 2 * I_IN + 3 * I_SQ + I_PW;
    for (int it = gw; it < NITEMS; it += NGW) {
        int r = it;
        if (r < I_UP) { transpose_item(P.in[3], 1024, DFF, (u16*)(ws + WS_W1A), 1, scr, r, lane); continue; } r -= I_UP;
        if (r < I_UP) { transpose_item(P.in[4], 1024, DFF, (u16*)(ws + WS_W1A), 2, scr, r, lane); continue; } r -= I_UP;
        if (r < I_DN) { transpose_item(P.in[5], DFF, 1024, (u16*)(ws + WS_W1D), 0, scr, r, lane); continue; } r -= I_DN;
        if (r < I_UP) { transpose_item(P.in[20], 1024, DFF, (u16*)(ws + WS_W2A), 1, scr, r, lane); continue; } r -= I_UP;
        if (r < I_UP) { transpose_item(P.in[21], 1024, DFF, (u16*)(ws + WS_W2A), 2, scr, r, lane); continue; } r -= I_UP;
        if (r < I_DN) { transpose_item(P.in[22], DFF, 1024, (u16*)(ws + WS_W2D), 0, scr, r, lane); continue; } r -= I_DN;
        if (r < I_IN) { transpose_item(P.in[8], 1024, DIN, (u16*)(ws + WS_WIN), 0, scr, r, lane); continue; } r -= I_IN;
        if (r < I_IN) { transpose_item(P.in[16], 1024, 2048, (u16*)(ws + WS_WKV), 0, scr, r, lane); continue; } r -= I_IN;
        if (r < I_SQ) { transpose_item(P.in[11], 1024, 1024, (u16*)(ws + WS_WOUT), 0, scr, r, lane); continue; } r -= I_SQ;
        if (r < I_SQ) { transpose_item(P.in[15], 1024, 1024, (u16*)(ws + WS_WQ), 0, scr, r, lane); continue; } r -= I_SQ;
        if (r < I_SQ) { transpose_item(P.in[17], 1024, 1024, (u16*)(ws + WS_WO), 0, scr, r, lane); continue; } r -= I_SQ;
        transpose_item(P.in[9], 512, 128, (u16*)(ws + WS_WPT), 0, scr, r, lane);
    }
    for (int m = gw; m < M; m += NGW) rms_row_to_f16(P.in[0] + (size_t)m * DM, P.in[2], (u16*)(ws + WS_XN) + (size_t)m * DM, lane);
    for (int m = gw; m < BATCH * NMEM; m += NGW) rms_row_to_f16(P.in[1] + (size_t)m * DM, P.in[14], (u16*)(ws + WS_MEMN) + (size_t)m * DM, lane);
    float* km = (float*)(ws + WS_KMEAN);
    for (int i = gw * 64 + lane; i < BATCH * NBLK * 512; i += NGW * 64) km[i] = 0.f;
}

template <int MODE>
__device__ __forceinline__ void nv_gemm(int gw, int NGW, int lane, const u16* A, int lda, const u16* Bt, int ldb, int Mr, int N, int K, void* C, int ldc, float sc, int sccols) {
    const int r = lane & 31, h = lane >> 5, ntn = N / 32, ntiles = (Mr / 32) * ntn;
    for (int wt = gw; wt < ntiles; wt += NGW) {
        const int m0 = (wt / ntn) * 32, n0 = (wt % ntn) * 32;
        const u16* ap = A + (size_t)(m0 + r) * lda + 8 * h;
        if (MODE == 2) {
            const int rg = (n0 >> 7) * 256 + (n0 & 127), ru = rg + 128;
            f32x16 ag = {}, au = {};
            const u16* bg = Bt + (size_t)(rg + r) * ldb + 8 * h;
            const u16* bu = Bt + (size_t)(ru + r) * ldb + 8 * h;
            for (int k = 0; k < K; k += 16) {
                const h8 a = *(const h8*)(ap + k), g = *(const h8*)(bg + k), u = *(const h8*)(bu + k);
                ag = __builtin_amdgcn_mfma_f32_32x32x16_f16(a, g, ag, 0, 0, 0);
                au = __builtin_amdgcn_mfma_f32_32x32x16_f16(a, u, au, 0, 0, 0);
            }
#pragma unroll
            for (int i = 0; i < 16; ++i) { const int row = m0 + (i & 3) + 8 * (i >> 2) + 4 * h, col = n0 + r;
                const float gv = ag[i], uv = au[i]; const float sg = gv / (1.f + __expf(-gv));
                ((u16*)C)[(size_t)row * ldc + col] = f2h(sg * uv); }
        } else {
            f32x16 acc = {};
            const u16* bp = Bt + (size_t)(n0 + r) * ldb + 8 * h;
            for (int k = 0; k < K; k += 16) {
                const h8 a = *(const h8*)(ap + k), b = *(const h8*)(bp + k);
                acc = __builtin_amdgcn_mfma_f32_32x32x16_f16(a, b, acc, 0, 0, 0);
            }
#pragma unroll
            for (int i = 0; i < 16; ++i) { const int row = m0 + (i & 3) + 8 * (i >> 2) + 4 * h, col = n0 + r;
                if (MODE == 0) ((u16*)C)[(size_t)row * ldc + col] = f2h(acc[i] * (col < sccols ? sc : 1.f));
                else ((float*)C)[(size_t)row * ldc + col] = acc[i]; }
        }
    }
}
__device__ __forceinline__ void nv_rownorm(int gw, int NGW, int lane, const float* F, const float* base, float w, const float* gpost, float* out, const float* gnext, u16* XN) {
    for (int row = gw; row < M; row += NGW) {
        const f32x4* fr = (const f32x4*)(F + (size_t)row * DM) + lane; const f32x4* br = (const f32x4*)(base + (size_t)row * DM) + lane;
        const f32x4* gp = (const f32x4*)gpost + lane;
        f32x4 f[4], x[4]; float s = 0.f;
#pragma unroll
        for (int j = 0; j < 4; ++j) { f[j] = fr[64 * j]; x[j] = br[64 * j]; s += (f[j].x * f[j].x + f[j].y * f[j].y) + (f[j].z * f[j].z + f[j].w * f[j].w); }
        const float r = 1.0f / sqrtf(wave_sum(s) * (1.f / DM) + EPS);
        float s2 = 0.f;
#pragma unroll
        for (int j = 0; j < 4; ++j) { const f32x4 g = gp[64 * j]; x[j] = x[j] + w * ((f[j] * r) * g); s2 += (x[j].x * x[j].x + x[j].y * x[j].y) + (x[j].z * x[j].z + x[j].w * x[j].w); }
        f32x4* orow = (f32x4*)(out + (size_t)row * DM) + lane;
#pragma unroll
        for (int j = 0; j < 4; ++j) orow[64 * j] = x[j];
        if (XN) {
            const float r2 = 1.0f / sqrtf(wave_sum(s2) * (1.f / DM) + EPS);
            const f32x4* gn = (const f32x4*)gnext + lane; u32x2* o8 = (u32x2*)(XN + (size_t)row * DM) + lane;
#pragma unroll
            for (int j = 0; j < 4; ++j) { const f32x4 g = gn[64 * j]; u32x2 o; o.x = pk2h(x[j].x * r2 * g.x, x[j].y * r2 * g.y); o.y = pk2h(x[j].z * r2 * g.z, x[j].w * r2 * g.w); o8[64 * j] = o; }
        }
    }
}
__device__ __forceinline__ void nv_kmean(int gw, int NGW, int lane, const u16* PROJ, float* KMEAN) {
    for (int i = gw * 64 + lane; i < BATCH * NBLK * 512; i += NGW * 64) { const int bb = i >> 9, c = i & 511; float s = 0.f;
        for (int r = 0; r < LBLK; ++r) s += h2f(PROJ[(size_t)(bb * LBLK + r) * DIN + 512 + c]);
        KMEAN[i] = s * (1.f / LBLK); }
}
__device__ __forceinline__ void nv_moba(int gw, int NGW, int lane, float* wl, const u16* PROJ, const float* KMEAN, u16* MIX) {
    float* sq = wl; float* sp = wl + 64;
    for (int gq = gw; gq < BATCH * NH * SEQ; gq += NGW) {
        const int t = gq % SEQ, h = (gq / SEQ) % NH, b = gq / (SEQ * NH);
        const size_t row = (size_t)b * SEQ + t;
        const int own = t / LBLK;
        const float qd = h2f(PROJ[row * DIN + h * HD + lane]);
        sq[lane] = qd;
        float v1 = -INFINITY, v2 = -INFINITY, v3 = -INFINITY; int i1 = -1, i2 = -1, i3 = -1;
        for (int n = 0; n < own; ++n) {
            const float g = wave_sum(qd * KMEAN[((size_t)b * NBLK + n) * 512 + h * HD + lane]);
            if (g > v1) { v3 = v2; i3 = i2; v2 = v1; i2 = i1; v1 = g; i1 = n; }
            else if (g > v2) { v3 = v2; i3 = i2; v2 = g; i2 = n; }
            else if (g > v3) { v3 = g; i3 = n; }
        }
        const float slope2 = exp2f(-(float)(h + 1)) * LOG2E;
        int blks[4] = {i1, i2, i3, own};
        float s[16]; float mx = -INFINITY;
#pragma unroll
        for (int sl = 0; sl < 4; ++sl) {
            const int blk = blks[sl];
#pragma unroll
            for (int c = 0; c < 4; ++c) {
                float sc = -INFINITY;
                if (blk >= 0) {
                    const int kpos = blk * LBLK + c * 64 + lane;
                    if (kpos <= t) {
                        const u16* kr = PROJ + ((size_t)b * SEQ + kpos) * DIN + 512 + h * HD; float a = 0.f;
#pragma unroll 2
                        for (int d = 0; d < 64; d += 8) { const h8 kv = *(const h8*)(kr + d);
#pragma unroll
                            for (int j = 0; j < 8; ++j) a += sq[d + j] * (float)kv[j]; }
                        sc = a - slope2 * (float)(t - kpos);
                    }
                }
                s[sl * 4 + c] = sc; mx = fmaxf(mx, sc);
            }
        }
        mx = wave_max(mx);
        float l = 0.f;
#pragma unroll
        for (int i = 0; i < 16; ++i) { const float p = exp2f(s[i] - mx); l += p; sp[i * 64 + lane] = p; }
        l = wave_sum(l);
        float o = 0.f;
#pragma unroll
        for (int sl = 0; sl < 4; ++sl) {
            const int blk = blks[sl];
            if (blk >= 0) {
                const u16* vb = PROJ + ((size_t)b * SEQ + blk * LBLK) * DIN + 1024 + h * HD + lane;
                for (int j = 0; j < LBLK; ++j) o += sp[sl * 256 + j] * h2f(vb[(size_t)j * DIN]);
            }
        }
        MIX[row * DM + h * HD + lane] = f2h(o / l);
    }
}
__device__ __forceinline__ void nv_pool(int gw, int NGW, int lane, float* wl, const u16* PROJ, const float* pool_w, const float* pool_scale, u16* MIX) {
    for (int it = gw; it < M * 4; it += NGW) {
        const int g = it & 3; const size_t row = it >> 2; const int t = (int)(row % SEQ);
        const int w = 2 << g, lo = max(t + 1 - w, 0), cnt = t + 1 - lo;
#pragma unroll
        for (int hh = 0; hh < 2; ++hh) { const int c = lane + 64 * hh; float s = 0.f;
            for (int j = lo; j <= t; ++j) s += h2f(PROJ[(row - (t - j)) * DIN + 1536 + g * 128 + c]);
            wl[c] = s / (float)cnt - h2f(PROJ[row * DIN + 1536 + g * 128 + c]); }
        float y0 = 0.f, y1 = 0.f;
        for (int k = 0; k < 128; ++k) { const float d = wl[k]; y0 += d * pool_w[((size_t)g * 128 + k) * 128 + lane]; y1 += d * pool_w[((size_t)g * 128 + k) * 128 + lane + 64]; }
        MIX[row * DM + 512 + g * 128 + lane] = f2h(y0 * pool_scale[g * 128 + lane]);
        MIX[row * DM + 512 + g * 128 + lane + 64] = f2h(y1 * pool_scale[g * 128 + lane + 64]);
    }
}
__device__ __forceinline__ void nv_xattn(int gw, int NGW, int lane, float* wl, const u16* XQ, const u16* KMEM, const u16* VMEMT, u16* XAO) {
    float* sq = wl; float* sp = wl + 256;
    for (int gi = gw; gi < M * XH; gi += NGW) {
        const int h = gi & 3; const size_t row = gi >> 2; const int b = (int)(row / SEQ);
#pragma unroll
        for (int j = 0; j < 4; ++j) sq[j * 64 + lane] = h2f(XQ[row * DM + h * XHD + j * 64 + lane]);
        float s[4]; float mx = -INFINITY;
#pragma unroll
        for (int j = 0; j < 4; ++j) { const int m = j * 64 + lane; const u16* kr = KMEM + ((size_t)b * NMEM + m) * DM + h * XHD; float a = 0.f;
#pragma unroll 2
            for (int d = 0; d < 256; d += 8) { const h8 kv = *(const h8*)(kr + d);
#pragma unroll
                for (int i = 0; i < 8; ++i) a += sq[d + i] * (float)kv[i]; }
            s[j] = a; mx = fmaxf(mx, a); }
        mx = wave_max(mx); float l = 0.f;
#pragma unroll
        for (int j = 0; j < 4; ++j) { const float p = exp2f(s[j] - mx); l += p; sp[j * 64 + lane] = p; }
        l = wave_sum(l);
#pragma unroll
        for (int j = 0; j < 4; ++j) { const int d = j * 64 + lane; const u16* vr = VMEMT + ((size_t)b * DM + h * XHD + d) * NMEM; float o = 0.f;
#pragma unroll 2
            for (int m = 0; m < 256; m += 8) { const h8 vv = *(const h8*)(vr + m);
#pragma unroll
                for (int i = 0; i < 8; ++i) o += sp[m + i] * (float)vv[i]; }
            XAO[row * DM + h * XHD + d] = f2h(o / l); }
    }
}

namespace pg8 {
#define PG8_LAS __attribute__((address_space(3)))
constexpr int BM = 256, BK = 64, HALF = 128, HTB = HALF * BK * 2, STAGE_BYTES = 8 * HTB, NXCD = 8, WGM = 8;
__host__ __device__ __forceinline__ int lds_byte(int r, int c) { const int st = (r >> 4) * 2 + (c >> 5), rr = r & 15, cc = c & 31, ob = rr * 64 + cc * 2; return st * 1024 + (ob ^ (((ob >> 9) & 1) << 5)); }
__host__ __device__ __forceinline__ void stage_rc(int b, int& R, int& C) { const int st = b / 1024, sb = b % 1024, swz = sb ^ (((sb >> 9) & 1) << 5); R = (st >> 1) * 16 + swz / 64; C = (st & 1) * 32 + (swz % 64) / 2; }
__host__ __device__ __forceinline__ int perm32(int rho) { const int n = rho >> 4, i = rho & 15; return 8 * (i >> 2) + 4 * n + (i & 3); }

struct Unit { int pm, pn; const char* a; const char* b; };
struct Gemm { int K, lda, ldb; };

struct GridOrder {
    int nM, nN, nwg, G, c;
    __device__ void init(int nM_, int nN_, int G_, int c_) { nM = nM_; nN = nN_; nwg = nM * nN; G = G_; c = c_; }
    __device__ bool tile(int i, int& pm, int& pn) const {
        const long L = (long)i * G + c; if (L >= nwg) return false;
        int wgid = (int)L; { const int q = nwg / NXCD, r = nwg % NXCD, xcd = wgid % NXCD, off = wgid / NXCD; wgid = (xcd < r ? xcd * (q + 1) : r * (q + 1) + (xcd - r) * q) + off; }
        const int nig = WGM * nN, gid = wgid / nig, fm = gid * WGM, gsz = (nM - fm) < WGM ? (nM - fm) : WGM;
        pm = fm + ((wgid % nig) % gsz); pn = (wgid % nig) / gsz; return true;
    }
};
struct DenseOrder : GridOrder {
    const u16* A; const u16* Bt; int lda, ldb;
    __device__ bool next(int i, Unit& u) const { if (!tile(i, u.pm, u.pn)) return false; u.a = (const char*)(A + (size_t)u.pm * BM * lda); u.b = (const char*)(Bt + (size_t)u.pn * BM * ldb); return true; }
};

struct EpiF32 {
    static constexpr bool PERM = false, AFTER_DRAIN = false;
    float* C; int ldc;
    __device__ __forceinline__ void operator()(const f32x4 (&acc)[2][2][4][2], const Unit& u, int wr, int wc, int fr, int fq) const {
        const int row0 = u.pm * BM + wr * 64 + fr, col0 = u.pn * BM + wc * 32 + 4 * fq;
#pragma unroll
        for (int ai = 0; ai < 2; ++ai)
#pragma unroll
            for (int m = 0; m < 4; ++m) { float* rowp = C + (size_t)(row0 + ai * HALF + m * 16) * ldc + col0;
#pragma unroll
                for (int bj = 0; bj < 2; ++bj)
#pragma unroll
                    for (int n = 0; n < 2; ++n) *(f32x4*)(rowp + bj * HALF + n * 16) = acc[ai][bj][m][n]; }
    }
};
struct EpiF16 {
    static constexpr bool PERM = true, AFTER_DRAIN = false;
    u16* O; int ldc; float scale0; int sctiles;
    __device__ __forceinline__ void operator()(const f32x4 (&acc)[2][2][4][2], const Unit& u, int wr, int wc, int fr, int fq) const {
        const int row0 = u.pm * BM + wr * 64 + fr, col0 = u.pn * BM + wc * 32 + 8 * fq;
        const float sc = u.pn < sctiles ? scale0 : 1.f;
#pragma unroll
        for (int ai = 0; ai < 2; ++ai)
#pragma unroll
            for (int m = 0; m < 4; ++m) { u16* rowp = O + (size_t)(row0 + ai * HALF + m * 16) * ldc + col0;
#pragma unroll
                for (int bj = 0; bj < 2; ++bj) { const f32x4 v0 = acc[ai][bj][m][0] * sc, v1 = acc[ai][bj][m][1] * sc;
                    u32x4 w; w.x = pk2h(v0[0], v0[1]); w.y = pk2h(v0[2], v0[3]); w.z = pk2h(v1[0], v1[1]); w.w = pk2h(v1[2], v1[3]);
                    *(u32x4*)(rowp + bj * HALF) = w; } }
    }
};
__device__ __forceinline__ float silu_mul(float g, float u) { return g * u * __builtin_amdgcn_rcpf(1.f + __builtin_amdgcn_exp2f(-LOG2E * g)); }
struct EpiSwiGLU {
    static constexpr bool PERM = true, AFTER_DRAIN = false;
    u16* O; int ldc;
    __device__ __forceinline__ void operator()(const f32x4 (&acc)[2][2][4][2], const Unit& u, int wr, int wc, int fr, int fq) const {
        const int row0 = u.pm * BM + wr * 64 + fr, col0 = u.pn * HALF + wc * 32 + 8 * fq;
#pragma unroll
        for (int ai = 0; ai < 2; ++ai)
#pragma unroll
            for (int m = 0; m < 4; ++m) { u16* rowp = O + (size_t)(row0 + ai * HALF + m * 16) * ldc + col0;
                const f32x4 g0 = acc[ai][0][m][0], g1 = acc[ai][0][m][1], u0 = acc[ai][1][m][0], u1 = acc[ai][1][m][1];
                u32x4 w; w.x = pk2h(silu_mul(g0[0], u0[0]), silu_mul(g0[1], u0[1])); w.y = pk2h(silu_mul(g0[2], u0[2]), silu_mul(g0[3], u0[3]));
                w.z = pk2h(silu_mul(g1[0], u1[0]), silu_mul(g1[1], u1[1])); w.w = pk2h(silu_mul(g1[2], u1[2]), silu_mul(g1[3], u1[3]));
                *(u32x4*)rowp = w; }
    }
};

template <class Epi, class Sched, bool ALIGN_EPI = false, bool SP2 = false>
__device__ __forceinline__ void gemm_phase(PG8_LAS unsigned char* lds, const Gemm g, const Sched& S, const Epi& E) {
    const int tid = threadIdx.x, wid = __builtin_amdgcn_readfirstlane(tid >> 6), lane = tid & 63, wr = wid >> 2, wc = wid & 3, fr = lane & 15, fq = lane >> 4;
    const int K = g.K, nt = K / BK;
    unsigned voffA[2], voffB[2];
#pragma unroll
    for (int i = 0; i < 2; ++i) { int R, C; stage_rc(tid * 16 + i * 8192, R, C); const int Rb = Epi::PERM ? ((R & ~31) + perm32(R & 31)) : R;
        voffA[i] = (unsigned)(R * g.lda + C) * 2u; voffB[i] = (unsigned)(Rb * g.ldb + C) * 2u; }
    const size_t kstep = (size_t)(BK * 2);
    const size_t hstepA = (size_t)HALF * g.lda * 2, hstepB = (size_t)HALF * g.ldb * 2;
    const unsigned ldsw = (unsigned)wid * 1024u;
    const int aoff = lds_byte(wr * 64 + fr, fq * 8), boff = lds_byte(wc * 32 + fr, fq * 8);
#define PG8_SA(b, h) (((b) * 2 + (h)) * HTB)
#define PG8_SB(b, h) ((4 + (b) * 2 + (h)) * HTB)
#define PG8_STAGE(bufoff, gbase, voff) do { _Pragma("unroll") for (int _i = 0; _i < 2; ++_i) \
        __builtin_amdgcn_global_load_lds((const unsigned*)((const char*)(gbase) + (voff)[_i]), (PG8_LAS unsigned*)(lds + (bufoff) + ldsw + _i * 8192), 16, 0, 0); } while (0)
#define PG8_LDA(dst, b, h) do { _Pragma("unroll") for (int m = 0; m < 4; ++m) _Pragma("unroll") for (int k = 0; k < 2; ++k) dst[m][k] = *(const PG8_LAS h8*)(lds + PG8_SA(b, h) + aoff + m * 2048 + k * 1024); } while (0)
#define PG8_LDB(dst, b, h) do { _Pragma("unroll") for (int n = 0; n < 2; ++n) _Pragma("unroll") for (int k = 0; k < 2; ++k) dst[n][k] = *(const PG8_LAS h8*)(lds + PG8_SB(b, h) + boff + n * 2048 + k * 1024); } while (0)
#define PG8_MMA(ai, bj, At, Bt) do { __builtin_amdgcn_s_setprio(1); _Pragma("unroll") for (int m = 0; m < 4; ++m) _Pragma("unroll") for (int n = 0; n < 2; ++n) _Pragma("unroll") for (int k = 0; k < 2; ++k) \
        acc[ai][bj][m][n] = __builtin_amdgcn_mfma_f32_16x16x32_f16(Bt[n][k], At[m][k], acc[ai][bj][m][n], 0, 0, 0); __builtin_amdgcn_s_setprio(0); } while (0)
#define PG8_WAIT_V(n) asm volatile("s_waitcnt vmcnt(" #n ")" ::: "memory")
#define PG8_WAIT_L(n) asm volatile("s_waitcnt lgkmcnt(" #n ")" ::: "memory")
#define PG8_BAR __builtin_amdgcn_s_barrier()
#define PG8_SCHED __builtin_amdgcn_sched_barrier(0)
    Unit cur, nxt; int ui = 0;
    if (!S.next(0, cur)) return;
    f32x4 acc[2][2][4][2];
#pragma unroll
    for (int a = 0; a < 2; ++a)
#pragma unroll
        for (int b = 0; b < 2; ++b)
#pragma unroll
            for (int m = 0; m < 4; ++m)
#pragma unroll
                for (int n = 0; n < 2; ++n) acc[a][b][m][n] = (f32x4){0.f, 0.f, 0.f, 0.f};
    h8 At[4][2], B0[2][2], B1[2][2];
    const char* cA = cur.a; const char* cB = cur.b;
    if constexpr (SP2) {
        PG8_STAGE(PG8_SB(0, 0), cB, voffB); PG8_STAGE(PG8_SB(0, 1), cB + hstepB, voffB); PG8_STAGE(PG8_SA(0, 0), cA, voffA); PG8_STAGE(PG8_SA(0, 1), cA + hstepA, voffA);
        if (wr == 1) PG8_BAR;
        PG8_WAIT_V(2); PG8_BAR;
        PG8_STAGE(PG8_SB(1, 0), cB + kstep, voffB); PG8_STAGE(PG8_SA(1, 0), cA + kstep, voffA); PG8_STAGE(PG8_SB(1, 1), cB + hstepB + kstep, voffB);
        PG8_WAIT_V(6); PG8_BAR;
    } else {
        PG8_STAGE(PG8_SB(0, 0), cB, voffB); PG8_STAGE(PG8_SA(0, 0), cA, voffA); PG8_STAGE(PG8_SB(0, 1), cB + hstepB, voffB); PG8_STAGE(PG8_SA(0, 1), cA + hstepA, voffA);
        if (wr == 1) PG8_BAR;
        PG8_WAIT_V(4); PG8_BAR;
        PG8_STAGE(PG8_SB(1, 0), cB + kstep, voffB); PG8_STAGE(PG8_SA(1, 0), cA + kstep, voffA); PG8_STAGE(PG8_SB(1, 1), cB + hstepB + kstep, voffB);
        PG8_WAIT_V(6); PG8_BAR;
    }
    for (;;) {
        const bool has_next = S.next(ui + 1, nxt);
        const char* nA = has_next ? nxt.a : cA; const char* nB = has_next ? nxt.b : cB;
        for (int t = 0; t < nt; t += 2) {
            const bool last = (t == nt - 2);
            const char* a1 = cA + (size_t)(t + 1) * kstep;
            const char* a2 = last ? nA : cA + (size_t)(t + 2) * kstep; const char* b2 = last ? nB : cB + (size_t)(t + 2) * kstep;
            const char* a3 = a2 + kstep; const char* b3 = b2 + kstep;
            if constexpr (SP2) {
            PG8_LDB(B0, 0, 0); PG8_LDB(B1, 0, 1); PG8_SCHED; PG8_LDA(At, 0, 0); PG8_STAGE(PG8_SA(1, 1), a1 + hstepA, voffA);
            PG8_WAIT_V(8); PG8_WAIT_L(0); PG8_BAR; PG8_MMA(0, 0, At, B0); PG8_MMA(0, 1, At, B1); PG8_BAR; PG8_SCHED;
            PG8_LDA(At, 0, 1); PG8_STAGE(PG8_SB(0, 0), b2, voffB); PG8_STAGE(PG8_SB(0, 1), b2 + hstepB, voffB); PG8_STAGE(PG8_SA(0, 0), a2, voffA);
            PG8_WAIT_V(8); PG8_WAIT_L(0); PG8_BAR; PG8_MMA(1, 0, At, B0); PG8_MMA(1, 1, At, B1); PG8_BAR; PG8_SCHED;
            PG8_LDB(B0, 1, 0); PG8_LDB(B1, 1, 1); PG8_SCHED; PG8_LDA(At, 1, 0); PG8_STAGE(PG8_SA(0, 1), a2 + hstepA, voffA);
            PG8_WAIT_V(8); PG8_WAIT_L(0); PG8_BAR; PG8_MMA(0, 0, At, B0); PG8_MMA(0, 1, At, B1); PG8_BAR; PG8_SCHED;
            PG8_LDA(At, 1, 1); PG8_STAGE(PG8_SB(1, 0), b3, voffB); PG8_STAGE(PG8_SB(1, 1), b3 + hstepB, voffB); PG8_STAGE(PG8_SA(1, 0), a3, voffA);
            PG8_WAIT_V(8); PG8_WAIT_L(0); PG8_BAR; PG8_MMA(1, 0, At, B0); PG8_MMA(1, 1, At, B1); PG8_BAR; PG8_SCHED;
            } else {
            PG8_LDB(B0, 0, 0); PG8_SCHED; PG8_LDA(At, 0, 0); PG8_STAGE(PG8_SA(1, 1), a1 + hstepA, voffA);
            PG8_WAIT_L(8); PG8_BAR; PG8_WAIT_L(0); PG8_MMA(0, 0, At, B0); PG8_BAR; PG8_SCHED;
            PG8_LDB(B1, 0, 1); PG8_STAGE(PG8_SB(0, 0), b2, voffB);
            PG8_BAR; PG8_WAIT_L(0); PG8_MMA(0, 1, At, B1); PG8_BAR;
            PG8_LDA(At, 0, 1); PG8_STAGE(PG8_SA(0, 0), a2, voffA);
            PG8_BAR; PG8_WAIT_L(0); PG8_MMA(1, 0, At, B0); PG8_BAR; PG8_SCHED;
            PG8_STAGE(PG8_SB(0, 1), b2 + hstepB, voffB);
            PG8_WAIT_V(6); PG8_BAR; PG8_MMA(1, 1, At, B1); PG8_BAR;
            PG8_LDB(B0, 1, 0); PG8_SCHED; PG8_LDA(At, 1, 0); PG8_STAGE(PG8_SA(0, 1), a2 + hstepA, voffA);
            PG8_WAIT_L(8); PG8_BAR; PG8_WAIT_L(0); PG8_MMA(0, 0, At, B0); PG8_BAR; PG8_SCHED;
            PG8_LDB(B1, 1, 1); PG8_STAGE(PG8_SB(1, 0), b3, voffB);
            PG8_BAR; PG8_WAIT_L(0); PG8_MMA(0, 1, At, B1); PG8_BAR;
            PG8_LDA(At, 1, 1); PG8_STAGE(PG8_SA(1, 0), a3, voffA);
            PG8_BAR; PG8_WAIT_L(0); PG8_MMA(1, 0, At, B0); PG8_BAR; PG8_SCHED;
            PG8_STAGE(PG8_SB(1, 1), b3 + hstepB, voffB);
            PG8_WAIT_V(6); PG8_BAR; PG8_MMA(1, 1, At, B1); PG8_BAR;
            }
        }
        if constexpr (ALIGN_EPI) { if (wr == 0) PG8_BAR; }
        if constexpr (!Epi::AFTER_DRAIN) { E(acc, cur, wr, wc, fr, fq); }
        if (!has_next) break;
#pragma unroll
        for (int a = 0; a < 2; ++a)
#pragma unroll
            for (int b = 0; b < 2; ++b)
#pragma unroll
                for (int m = 0; m < 4; ++m)
#pragma unroll
                    for (int n = 0; n < 2; ++n) acc[a][b][m][n] = (f32x4){0.f, 0.f, 0.f, 0.f};
        cur = nxt; cA = nA; cB = nB; ++ui;
        if constexpr (ALIGN_EPI) { if (wr == 1) PG8_BAR; }
    }
    PG8_WAIT_V(0);
    if constexpr (!ALIGN_EPI) { if (wr == 0) PG8_BAR; }
    PG8_BAR;
    if constexpr (Epi::AFTER_DRAIN) { E.fused(acc, cur, wr, wc, fr, fq, lds, wid, lane); }
#undef PG8_SA
#undef PG8_SB
#undef PG8_STAGE
#undef PG8_LDA
#undef PG8_LDB
#undef PG8_MMA
#undef PG8_WAIT_V
#undef PG8_WAIT_L
#undef PG8_BAR
#undef PG8_SCHED
}
}

namespace cg = cooperative_groups;
constexpr int NWAVES = 8, NTHREADS = NWAVES * 64;
constexpr int LDS_BYTES = 147456;
struct Args { Ptrs p; };

__global__ void __launch_bounds__(NTHREADS, 2) mega(Args args) {
    extern __shared__ __attribute__((aligned(16))) unsigned char lds[];
    cg::grid_group grid = cg::this_grid();
    const Ptrs& P = args.p;
    unsigned char* ws = P.ws;
    const int tid = threadIdx.x, lane = tid & 63, wave = __builtin_amdgcn_readfirstlane(tid >> 6);
    const int G = gridDim.x, gw = blockIdx.x * NWAVES + wave, NGW = G * NWAVES;
    float* wl = (float*)(lds + wave * 16384);
    u16 *XN = (u16*)(ws + WS_XN), *ACT = (u16*)(ws + WS_ACT), *PROJ = (u16*)(ws + WS_PROJ), *MIX = (u16*)(ws + WS_MIX), *XQ = (u16*)(ws + WS_XQ), *XAO = (u16*)(ws + WS_XAO);
    u16 *MEMN = (u16*)(ws + WS_MEMN), *KMEM = (u16*)(ws + WS_KMEM), *VMEMT = (u16*)(ws + WS_VMEMT);
    float *F32A = (float*)(ws + WS_F32A), *F32B = (float*)(ws + WS_F32B), *KMEAN = (float*)(ws + WS_KMEAN), *OUT = P.out;
#define GSYNC() grid.sync()
    PG8_LAS unsigned char* ldsl = (PG8_LAS unsigned char*)lds;
#define DENSE(EPI, epi, Aptr, lda_, Btptr, ldb_, nM_, nN_, K_, ALIGN) do { pg8::DenseOrder S_; S_.init(nM_, nN_, G, (int)blockIdx.x); S_.A = (Aptr); S_.Bt = (Btptr); S_.lda = (lda_); S_.ldb = (ldb_); \
        pg8::gemm_phase<EPI, pg8::DenseOrder, ALIGN, true>(ldsl, pg8::Gemm{K_, lda_, ldb_}, S_, epi); } while (0)
    prologue(P, gw, NGW, lane, wl);
    GSYNC();
    { pg8::EpiSwiGLU e{ACT, DFF}; DENSE(pg8::EpiSwiGLU, e, XN, DM, (u16*)(ws + WS_W1A), DM, M / 256, 2 * DFF / 256, DM, true); }
    { pg8::EpiF16 e{KMEM, DM, 1.f, 0}; DENSE(pg8::EpiF16, e, MEMN, DM, (u16*)(ws + WS_WKV), DM, BATCH * NMEM / 256, DM / 256, DM, true); }
    for (int b = 0; b < BATCH; ++b) { pg8::EpiF16 e{VMEMT + (size_t)b * DM * NMEM, NMEM, 1.f, 0}; DENSE(pg8::EpiF16, e, (u16*)(ws + WS_WKV) + (size_t)DM * DM, DM, MEMN + (size_t)b * NMEM * DM, DM, DM / 256, NMEM / 256, DM, true); }
    GSYNC();
    { pg8::EpiF32 e{F32A, DM}; DENSE(pg8::EpiF32, e, ACT, DFF, (u16*)(ws + WS_W1D), DFF, M / 256, DM / 256, DFF, false); }
    GSYNC();
    nv_rownorm(gw, NGW, lane, F32A, P.in[0], 0.5f, P.in[6], OUT, P.in[7], XN);
    GSYNC();
    { pg8::EpiF16 e{PROJ, DIN, QSCALE, 2}; DENSE(pg8::EpiF16, e, XN, DM, (u16*)(ws + WS_WIN), DM, M / 256, DIN / 256, DM, true); }
    GSYNC();
    nv_kmean(gw, NGW, lane, PROJ, KMEAN);
    GSYNC();
    nv_moba(gw, NGW, lane, wl, PROJ, KMEAN, MIX);
    nv_pool(gw, NGW, lane, wl, PROJ, P.in[9], P.in[10], MIX);
    GSYNC();
    { pg8::EpiF32 e{F32B, DM}; DENSE(pg8::EpiF32, e, MIX, DM, (u16*)(ws + WS_WOUT), DM, M / 256, DM / 256, DM, false); }
    GSYNC();
    nv_rownorm(gw, NGW, lane, F32B, OUT, 1.0f, P.in[12], OUT, P.in[13], XN);
    GSYNC();
    { pg8::EpiF16 e{XQ, DM, XQSCALE, 4}; DENSE(pg8::EpiF16, e, XN, DM, (u16*)(ws + WS_WQ), DM, M / 256, DM / 256, DM, false); }
    GSYNC();
    nv_xattn(gw, NGW, lane, wl, XQ, KMEM, VMEMT, XAO);
    GSYNC();
    { pg8::EpiF32 e{F32B, DM}; DENSE(pg8::EpiF32, e, XAO, DM, (u16*)(ws + WS_WO), DM, M / 256, DM / 256, DM, false); }
    GSYNC();
    nv_rownorm(gw, NGW, lane, F32B, OUT, 1.0f, P.in[18], OUT, P.in[19], XN);
    GSYNC();
    { pg8::EpiSwiGLU e{ACT, DFF}; DENSE(pg8::EpiSwiGLU, e, XN, DM, (u16*)(ws + WS_W2A), DM, M / 256, 2 * DFF / 256, DM, true); }
    GSYNC();
    { pg8::EpiF32 e{F32A, DM}; DENSE(pg8::EpiF32, e, ACT, DFF, (u16*)(ws + WS_W2D), DFF, M / 256, DM / 256, DFF, false); }
    GSYNC();
    nv_rownorm(gw, NGW, lane, F32A, OUT, 0.5f, P.in[23], OUT, nullptr, nullptr);
}

extern "C" void kernel_launch(void* const* d_in, const int* in_sizes, int n_in, void* d_out, int out_size, void* d_ws, size_t ws_size, hipStream_t stream) {
    static int grid = 0;
    if (grid == 0) {
        if (n_in != 24 || out_size != M * DM || ws_size < WS_END) { fprintf(stderr, "kernel_launch: unexpected shapes (n_in %d out %d ws %zu)\n", n_in, out_size, ws_size); grid = -1; return; }
        int dev = 0, cus = 0, per_cu = 0;
        if (hipGetDevice(&dev) != hipSuccess || hipDeviceGetAttribute(&cus, hipDeviceAttributeMultiprocessorCount, dev) != hipSuccess) { grid = -1; return; }
        if (hipFuncSetAttribute((const void*)mega, hipFuncAttributeMaxDynamicSharedMemorySize, LDS_BYTES) != hipSuccess) { fprintf(stderr, "kernel_launch: hipFuncSetAttribute failed\n"); grid = -1; return; }
        if (hipOccupancyMaxActiveBlocksPerMultiprocessor(&per_cu, (const void*)mega, NTHREADS, LDS_BYTES) != hipSuccess || per_cu < 1) { fprintf(stderr, "kernel_launch: occupancy query failed (%d)\n", per_cu); grid = -1; return; }
        grid = cus * 1;
        fprintf(stderr, "kernel_launch: %d CUs, occupancy %d/CU, grid %d\n", cus, per_cu, grid);
    }
    if (grid < 0) return;
    (void)hipMemsetAsync((unsigned char*)d_ws + WS_CTL, 0, CTL_BYTES, stream);
    Args a{};
    for (int i = 0; i < 24; ++i) a.p.in[i] = (const float*)d_in[i];
    a.p.out = (float*)d_out; a.p.ws = (unsigned char*)d_ws;
    void* kargs[] = {&a};
    hipError_t e = hipLaunchCooperativeKernel((const void*)mega, dim3(grid), dim3(NTHREADS), kargs, LDS_BYTES, stream);
    if (e != hipSuccess) fprintf(stderr, "kernel_launch: cooperative launch failed: %s (grid %d)\n", hipGetErrorString(e), grid);
}
```

```cpp
#include <hip/hip_runtime.h>
#include <hip/hip_cooperative_groups.h>
#include <cstdio>
#include <cstdint>

typedef unsigned short u16;
typedef _Float16 h8 __attribute__((ext_vector_type(8)));
typedef _Float16 h2 __attribute__((ext_vector_type(2)));
typedef float f32x2 __attribute__((ext_vector_type(2)));
typedef float f32x4 __attribute__((ext_vector_type(4)));
typedef float f32x16 __attribute__((ext_vector_type(16)));
typedef unsigned u32x4 __attribute__((ext_vector_type(4)));
typedef unsigned u32x2 __attribute__((ext_vector_type(2)));

constexpr int BATCH = 4, SEQ = 4096, DM = 1024, M = BATCH * SEQ;
constexpr int NH = 8, HD = 64, DATT = 512, DPOOL = 512, DIN = 2048;
constexpr int LBLK = 256, NBLK = SEQ / LBLK;
constexpr int NMEM = 256, XH = 4, XHD = 256;
constexpr int DFF = 2816;
constexpr float EPS = 1e-6f;
constexpr float LOG2E = 1.4426950408889634f;
constexpr float QSCALE = 0.125f * LOG2E;
constexpr float XQSCALE = 0.0625f * LOG2E;

constexpr size_t MiB = 1u << 20;
constexpr size_t WS_CTL = 0, CTL_BYTES = 1 * MiB;
constexpr size_t WS_KMEAN = 1 * MiB;
constexpr size_t WS_XBUF = 2 * MiB;
constexpr size_t WS_MEMN = 5 * MiB;
constexpr size_t WS_KMEM = 7 * MiB;
constexpr size_t WS_VMEMT = 9 * MiB;
constexpr size_t WS_WPT = 11 * MiB;
constexpr size_t WS_W1A = 12 * MiB;
constexpr size_t WS_W1D = 23 * MiB;
constexpr size_t WS_W2A = WS_W1D + 5 * MiB + MiB / 2;
constexpr size_t WS_W2D = WS_W2A + 11 * MiB;
constexpr size_t WS_WIN = 45 * MiB;
constexpr size_t WS_WOUT = 49 * MiB;
constexpr size_t WS_WQ = 51 * MiB;
constexpr size_t WS_WKV = 53 * MiB;
constexpr size_t WS_WO = 57 * MiB;
constexpr size_t WS_XN = 60 * MiB;
constexpr size_t WS_R1 = 92 * MiB;
constexpr size_t WS_ACT = WS_R1, WS_PROJ = WS_R1, WS_XQ = WS_R1, WS_XP = WS_R1 + 32 * MiB, WS_F32B = WS_R1;
constexpr size_t WS_R2 = 180 * MiB;
constexpr size_t WS_MIX = WS_R2, WS_XAO = WS_R2 + 32 * MiB, WS_F32A = WS_R2;
constexpr size_t WS_END = 244 * MiB;

__device__ __forceinline__ float h2f(u16 v) { return (float)__builtin_bit_cast(_Float16, v); }
__device__ __forceinline__ u16 f2h(float f) { return __builtin_bit_cast(u16, (_Float16)f); }
__device__ __forceinline__ unsigned pk2h(float lo, float hi) { f32x2 v = {lo, hi}; h2 h = __builtin_convertvector(v, h2); return __builtin_bit_cast(unsigned, h); }
__device__ __forceinline__ float wave_sum(float v) {
#pragma unroll
    for (int o = 1; o < 64; o <<= 1) v += __shfl_xor(v, o);
    return v;
}
__device__ __forceinline__ float wave_max(float v) {
#pragma unroll
    for (int o = 1; o < 64; o <<= 1) v = fmaxf(v, __shfl_xor(v, o));
    return v;
}

__device__ __forceinline__ int fresh_lane() { int l; asm volatile("v_mbcnt_lo_u32_b32 %0, -1, 0\n\tv_mbcnt_hi_u32_b32 %0, -1, %0" : "=v"(l)); return l; }

struct Ptrs {
    const float* in[24];
    float* out;
    unsigned char* ws;
};

__device__ __forceinline__ int rowmap(int map, int n) { return map == 0 ? n : ((n >> 7) * 256 + (map == 2 ? 128 : 0) + (n & 127)); }
__device__ __forceinline__ void transpose_item(const float* W, int K, int N, u16* WT, int map, float* scr, int item, int lane) {
    const int nblk = N / 32, kb = item / nblk, nb = item % nblk, k0 = 64 * kb, n0 = 32 * nb;
#pragma unroll 8
    for (int i = 0; i < 32; ++i) { const int kk = 2 * i + (lane >> 5); scr[kk * 33 + (lane & 31)] = W[(size_t)(k0 + kk) * N + n0 + (lane & 31)]; }
    asm volatile("s_waitcnt lgkmcnt(0)" ::: "memory");
    const int c = lane & 7;
    const int r0 = rowmap(map, n0);
#pragma unroll
    for (int j = 0; j < 4; ++j) { const int n = (lane >> 3) + 8 * j; const float* s = scr + (8 * c) * 33 + n;
        u32x4 o; o.x = pk2h(s[0 * 33], s[1 * 33]); o.y = pk2h(s[2 * 33], s[3 * 33]); o.z = pk2h(s[4 * 33], s[5 * 33]); o.w = pk2h(s[6 * 33], s[7 * 33]);
        *(u32x4*)(WT + (size_t)(r0 + n) * K + k0 + 8 * c) = o; }
    asm volatile("s_waitcnt lgkmcnt(0)" ::: "memory");
}
__device__ __forceinline__ void rms_row_to_f16(const float* xrow, const float* g, u16* orow, int lane) {
    const f32x4* xr = (const f32x4*)xrow + lane; const f32x4* gr = (const f32x4*)g + lane;
    f32x4 v[4]; float s = 0.f;
#pragma unroll
    for (int j = 0; j < 4; ++j) { v[j] = xr[64 * j]; s += (v[j].x * v[j].x + v[j].y * v[j].y) + (v[j].z * v[j].z + v[j].w * v[j].w); }
    const float r = 1.0f / sqrtf(wave_sum(s) * (1.f / DM) + EPS);
    u32x2* o8 = (u32x2*)orow + lane;
#pragma unroll
    for (int j = 0; j < 4; ++j) { const f32x4 gg = gr[64 * j]; u32x2 w; w.x = pk2h(v[j].x * r * gg.x, v[j].y * r * gg.y); w.y = pk2h(v[j].z * r * gg.z, v[j].w * r * gg.w); o8[64 * j] = w; }
}
struct TItem { int idx, K, N; size_t dst; int map; };
__device__ __forceinline__ void prologue(const Ptrs& P, int gw, int NGW, int lane, float* scr) {
    unsigned char* ws = P.ws;
    constexpr int I_UP = 16 * 88, I_DN = 44 * 32, I_IN = 16 * 64, I_SQ = 16 * 32, I_PW = 8 * 4;
    constexpr int NITEMS = 4 * I_UP + 2 * I_DN + 2 * I_IN + 3 * I_SQ + I_PW;
    for (int it = gw; it < NITEMS; it += NGW) {
        int r = it;
        if (r < I_UP) { transpose_item(P.in[3], 1024, DFF, (u16*)(ws + WS_W1A), 1, scr, r, lane); continue; } r -= I_UP;
        if (r < I_UP) { transpose_item(P.in[4], 1024, DFF, (u16*)(ws + WS_W1A), 2, scr, r, lane); continue; } r -= I_UP;
        if (r < I_DN) { transpose_item(P.in[5], DFF, 1024, (u16*)(ws + WS_W1D), 0, scr, r, lane); continue; } r -= I_DN;
        if (r < I_UP) { transpose_item(P.in[20], 1024, DFF, (u16*)(ws + WS_W2A), 1, scr, r, lane); continue; } r -= I_UP;
        if (r < I_UP) { transpose_item(P.in[21], 1024, DFF, (u16*)(ws + WS_W2A), 2, scr, r, lane); continue; } r -= I_UP;
        if (r < I_DN) { transpose_item(P.in[22], DFF, 1024, (u16*)(ws + WS_W2D), 0, scr, r, lane); continue; } r -= I_DN;
        if (r < I_IN) { transpose_item(P.in[8], 1024, DIN, (u16*)(ws + WS_WIN), 0, scr, r, lane); continue; } r -= I_IN;
        if (r < I_IN) { transpose_item(P.in[16], 1024, 2048, (u16*)(ws + WS_WKV), 0, scr, r, lane); continue; } r -= I_IN;
        if (r < I_SQ) { transpose_item(P.in[11], 1024, 1024, (u16*)(ws + WS_WOUT), 0, scr, r, lane); continue; } r -= I_SQ;
        if (r < I_SQ) { transpose_item(P.in[15], 1024, 1024, (u16*)(ws + WS_WQ), 0, scr, r, lane); continue; } r -= I_SQ;
        if (r < I_SQ) { transpose_item(P.in[17], 1024, 1024, (u16*)(ws + WS_WO), 0, scr, r, lane); continue; } r -= I_SQ;
        transpose_item(P.in[9], 512, 128, (u16*)(ws + WS_WPT), 0, scr, r, lane);
    }
    for (int m = gw; m < M; m += NGW) rms_row_to_f16(P.in[0] + (size_t)m * DM, P.in[2], (u16*)(ws + WS_XN) + (size_t)m * DM, lane);
    for (int m = gw; m < BATCH * NMEM; m += NGW) rms_row_to_f16(P.in[1] + (size_t)m * DM, P.in[14], (u16*)(ws + WS_MEMN) + (size_t)m * DM, lane);
    float* km = (float*)(ws + WS_KMEAN);
    for (int i = gw * 64 + lane; i < BATCH * NBLK * 512; i += NGW * 64) km[i] = 0.f;
}

template <int MODE>
__device__ __forceinline__ void nv_gemm(int gw, int NGW, int lane, const u16* A, int lda, const u16* Bt, int ldb, int Mr, int N, int K, void* C, int ldc, float sc, int sccols) {
    const int r = lane & 31, h = lane >> 5, ntn = N / 32, ntiles = (Mr / 32) * ntn;
    for (int wt = gw; wt < ntiles; wt += NGW) {
        const int m0 = (wt / ntn) * 32, n0 = (wt % ntn) * 32;
        const u16* ap = A + (size_t)(m0 + r) * lda + 8 * h;
        if (MODE == 2) {
            const int rg = (n0 >> 7) * 256 + (n0 & 127), ru = rg + 128;
            f32x16 ag = {}, au = {};
            const u16* bg = Bt + (size_t)(rg + r) * ldb + 8 * h;
            const u16* bu = Bt + (size_t)(ru + r) * ldb + 8 * h;
            for (int k = 0; k < K; k += 16) {
                const h8 a = *(const h8*)(ap + k), g = *(const h8*)(bg + k), u = *(const h8*)(bu + k);
                ag = __builtin_amdgcn_mfma_f32_32x32x16_f16(a, g, ag, 0, 0, 0);
                au = __builtin_amdgcn_mfma_f32_32x32x16_f16(a, u, au, 0, 0, 0);
            }
#pragma unroll
            for (int i = 0; i < 16; ++i) { const int row = m0 + (i & 3) + 8 * (i >> 2) + 4 * h, col = n0 + r;
                const float gv = ag[i], uv = au[i]; const float sg = gv / (1.f + __expf(-gv));
                ((u16*)C)[(size_t)row * ldc + col] = f2h(sg * uv); }
        } else {
            f32x16 acc = {};
            const u16* bp = Bt + (size_t)(n0 + r) * ldb + 8 * h;
            for (int k = 0; k < K; k += 16) {
                const h8 a = *(const h8*)(ap + k), b = *(const h8*)(bp + k);
                acc = __builtin_amdgcn_mfma_f32_32x32x16_f16(a, b, acc, 0, 0, 0);
            }
#pragma unroll
            for (int i = 0; i < 16; ++i) { const int row = m0 + (i & 3) + 8 * (i >> 2) + 4 * h, col = n0 + r;
                if (MODE == 0) ((u16*)C)[(size_t)row * ldc + col] = f2h(acc[i] * (col < sccols ? sc : 1.f));
                else ((float*)C)[(size_t)row * ldc + col] = acc[i]; }
        }
    }
}
__device__ __forceinline__ void nv_rownorm(int gw, int NGW, int lane, const float* F, const float* base, float w, const float* gpost, float* out, const float* gnext, u16* XN) {
    for (int row = gw; row < M; row += NGW) {
        const f32x4* fr = (const f32x4*)(F + (size_t)row * DM) + lane; const f32x4* br = (const f32x4*)(base + (size_t)row * DM) + lane;
        const f32x4* gp = (const f32x4*)gpost + lane;
        f32x4 f[4], x[4]; float s = 0.f;
#pragma unroll
        for (int j = 0; j < 4; ++j) { f[j] = fr[64 * j]; x[j] = br[64 * j]; s += (f[j].x * f[j].x + f[j].y * f[j].y) + (f[j].z * f[j].z + f[j].w * f[j].w); }
        const float r = 1.0f / sqrtf(wave_sum(s) * (1.f / DM) + EPS);
        float s2 = 0.f;
#pragma unroll
        for (int j = 0; j < 4; ++j) { const f32x4 g = gp[64 * j]; x[j] = x[j] + w * ((f[j] * r) * g); s2 += (x[j].x * x[j].x + x[j].y * x[j].y) + (x[j].z * x[j].z + x[j].w * x[j].w); }
        f32x4* orow = (f32x4*)(out + (size_t)row * DM) + lane;
#pragma unroll
        for (int j = 0; j < 4; ++j) orow[64 * j] = x[j];
        if (XN) {
            const float r2 = 1.0f / sqrtf(wave_sum(s2) * (1.f / DM) + EPS);
            const f32x4* gn = (const f32x4*)gnext + lane; u32x2* o8 = (u32x2*)(XN + (size_t)row * DM) + lane;
#pragma unroll
            for (int j = 0; j < 4; ++j) { const f32x4 g = gn[64 * j]; u32x2 o; o.x = pk2h(x[j].x * r2 * g.x, x[j].y * r2 * g.y); o.y = pk2h(x[j].z * r2 * g.z, x[j].w * r2 * g.w); o8[64 * j] = o; }
        }
    }
}
__device__ __forceinline__ void nv_kmean(int gw, int NGW, int lane, const u16* PROJ, float* KMEAN) {
    for (int i = gw * 64 + lane; i < BATCH * NBLK * 512; i += NGW * 64) { const int bb = i >> 9, c = i & 511; float s = 0.f;
        for (int r = 0; r < LBLK; ++r) s += h2f(PROJ[(size_t)(bb * LBLK + r) * DIN + 512 + c]);
        KMEAN[i] = s * (1.f / LBLK); }
}
__device__ __forceinline__ void nv_moba(int gw, int NGW, int lane, float* wl, const u16* PROJ, const float* KMEAN, u16* MIX) {
    float* sq = wl; float* sp = wl + 64;
    for (int gq = gw; gq < BATCH * NH * SEQ; gq += NGW) {
        const int t = gq % SEQ, h = (gq / SEQ) % NH, b = gq / (SEQ * NH);
        const size_t row = (size_t)b * SEQ + t;
        const int own = t / LBLK;
        const float qd = h2f(PROJ[row * DIN + h * HD + lane]);
        sq[lane] = qd;
        float v1 = -INFINITY, v2 = -INFINITY, v3 = -INFINITY; int i1 = -1, i2 = -1, i3 = -1;
        for (int n = 0; n < own; ++n) {
            const float g = wave_sum(qd * KMEAN[((size_t)b * NBLK + n) * 512 + h * HD + lane]);
            if (g > v1) { v3 = v2; i3 = i2; v2 = v1; i2 = i1; v1 = g; i1 = n; }
            else if (g > v2) { v3 = v2; i3 = i2; v2 = g; i2 = n; }
            else if (g > v3) { v3 = g; i3 = n; }
        }
        const float slope2 = exp2f(-(float)(h + 1)) * LOG2E;
        int blks[4] = {i1, i2, i3, own};
        float s[16]; float mx = -INFINITY;
#pragma unroll
        for (int sl = 0; sl < 4; ++sl) {
            const int blk = blks[sl];
#pragma unroll
            for (int c = 0; c < 4; ++c) {
                float sc = -INFINITY;
                if (blk >= 0) {
                    const int kpos = blk * LBLK + c * 64 + lane;
                    if (kpos <= t) {
                        const u16* kr = PROJ + ((size_t)b * SEQ + kpos) * DIN + 512 + h * HD; float a = 0.f;
#pragma unroll 2
                        for (int d = 0; d < 64; d += 8) { const h8 kv = *(const h8*)(kr + d);
#pragma unroll
                            for (int j = 0; j < 8; ++j) a += sq[d + j] * (float)kv[j]; }
                        sc = a - slope2 * (float)(t - kpos);
                    }
                }
                s[sl * 4 + c] = sc; mx = fmaxf(mx, sc);
            }
        }
        mx = wave_max(mx);
        float l = 0.f;
#pragma unroll
        for (int i = 0; i < 16; ++i) { const float p = exp2f(s[i] - mx); l += p; sp[i * 64 + lane] = p; }
        l = wave_sum(l);
        float o = 0.f;
#pragma unroll
        for (int sl = 0; sl < 4; ++sl) {
            const int blk = blks[sl];
            if (blk >= 0) {
                const u16* vb = PROJ + ((size_t)b * SEQ + blk * LBLK) * DIN + 1024 + h * HD + lane;
                for (int j = 0; j < LBLK; ++j) o += sp[sl * 256 + j] * h2f(vb[(size_t)j * DIN]);
            }
        }
        MIX[row * DM + h * HD + lane] = f2h(o / l);
    }
}
__device__ __forceinline__ void nv_pool(int gw, int NGW, int lane, float* wl, const u16* PROJ, const float* pool_w, const float* pool_scale, u16* MIX) {
    for (int it = gw; it < M * 4; it += NGW) {
        const int g = it & 3; const size_t row = it >> 2; const int t = (int)(row % SEQ);
        const int w = 2 << g, lo = max(t + 1 - w, 0), cnt = t + 1 - lo;
#pragma unroll
        for (int hh = 0; hh < 2; ++hh) { const int c = lane + 64 * hh; float s = 0.f;
            for (int j = lo; j <= t; ++j) s += h2f(PROJ[(row - (t - j)) * DIN + 1536 + g * 128 + c]);
            wl[c] = s / (float)cnt - h2f(PROJ[row * DIN + 1536 + g * 128 + c]); }
        float y0 = 0.f, y1 = 0.f;
        for (int k = 0; k < 128; ++k) { const float d = wl[k]; y0 += d * pool_w[((size_t)g * 128 + k) * 128 + lane]; y1 += d * pool_w[((size_t)g * 128 + k) * 128 + lane + 64]; }
        MIX[row * DM + 512 + g * 128 + lane] = f2h(y0 * pool_scale[g * 128 + lane]);
        MIX[row * DM + 512 + g * 128 + lane + 64] = f2h(y1 * pool_scale[g * 128 + lane + 64]);
    }
}
__device__ __forceinline__ void nv_xattn(int gw, int NGW, int lane, float* wl, const u16* XQ, const u16* KMEM, const u16* VMEMT, u16* XAO) {
    float* sq = wl; float* sp = wl + 256;
    for (int gi = gw; gi < M * XH; gi += NGW) {
        const int h = gi & 3; const size_t row = gi >> 2; const int b = (int)(row / SEQ);
#pragma unroll
        for (int j = 0; j < 4; ++j) sq[j * 64 + lane] = h2f(XQ[row * DM + h * XHD + j * 64 + lane]);
        float s[4]; float mx = -INFINITY;
#pragma unroll
        for (int j = 0; j < 4; ++j) { const int m = j * 64 + lane; const u16* kr = KMEM + ((size_t)b * NMEM + m) * DM + h * XHD; float a = 0.f;
#pragma unroll 2
            for (int d = 0; d < 256; d += 8) { const h8 kv = *(const h8*)(kr + d);
#pragma unroll
                for (int i = 0; i < 8; ++i) a += sq[d + i] * (float)kv[i]; }
            s[j] = a; mx = fmaxf(mx, a); }
        mx = wave_max(mx); float l = 0.f;
#pragma unroll
        for (int j = 0; j < 4; ++j) { const float p = exp2f(s[j] - mx); l += p; sp[j * 64 + lane] = p; }
        l = wave_sum(l);
#pragma unroll
        for (int j = 0; j < 4; ++j) { const int d = j * 64 + lane; const u16* vr = VMEMT + ((size_t)b * DM + h * XHD + d) * NMEM; float o = 0.f;
#pragma unroll 2
            for (int m = 0; m < 256; m += 8) { const h8 vv = *(const h8*)(vr + m);
#pragma unroll
                for (int i = 0; i < 8; ++i) o += sp[m + i] * (float)vv[i]; }
            XAO[row * DM + h * XHD + d] = f2h(o / l); }
    }
}

namespace pg8 {
#define PG8_LAS __attribute__((address_space(3)))
constexpr int BM = 256, BK = 64, HALF = 128, HTB = HALF * BK * 2, STAGE_BYTES = 8 * HTB, NXCD = 8, WGM = 8;
__host__ __device__ __forceinline__ int lds_byte(int r, int c) { const int st = (r >> 4) * 2 + (c >> 5), rr = r & 15, cc = c & 31, ob = rr * 64 + cc * 2; return st * 1024 + (ob ^ (((ob >> 9) & 1) << 5)); }
__host__ __device__ __forceinline__ void stage_rc(int b, int& R, int& C) { const int st = b / 1024, sb = b % 1024, swz = sb ^ (((sb >> 9) & 1) << 5); R = (st >> 1) * 16 + swz / 64; C = (st & 1) * 32 + (swz % 64) / 2; }
__host__ __device__ __forceinline__ int perm32(int rho) { const int n = rho >> 4, i = rho & 15; return 8 * (i >> 2) + 4 * n + (i & 3); }

struct Unit { int pm, pn; const char* a; const char* b; };
struct Gemm { int K, lda, ldb; };

struct GridOrder {
    int nM, nN, nwg, G, c;
    __device__ void init(int nM_, int nN_, int G_, int c_) { nM = nM_; nN = nN_; nwg = nM * nN; G = G_; c = c_; }
    __device__ bool tile(int i, int& pm, int& pn) const {
        const long L = (long)i * G + c; if (L >= nwg) return false;
        int wgid = (int)L; { const int q = nwg / NXCD, r = nwg % NXCD, xcd = wgid % NXCD, off = wgid / NXCD; wgid = (xcd < r ? xcd * (q + 1) : r * (q + 1) + (xcd - r) * q) + off; }
        const int nig = WGM * nN, gid = wgid / nig, fm = gid * WGM, gsz = (nM - fm) < WGM ? (nM - fm) : WGM;
        pm = fm + ((wgid % nig) % gsz); pn = (wgid % nig) / gsz; return true;
    }
};
struct DenseOrder : GridOrder {
    const u16* A; const u16* Bt; int lda, ldb;
    __device__ bool next(int i, Unit& u) const { if (!tile(i, u.pm, u.pn)) return false; u.a = (const char*)(A + (size_t)u.pm * BM * lda); u.b = (const char*)(Bt + (size_t)u.pn * BM * ldb); return true; }
};

struct EpiF32 {
    static constexpr bool PERM = false, AFTER_DRAIN = false;
    float* C; int ldc;
    __device__ __forceinline__ void operator()(const f32x4 (&acc)[2][2][4][2], const Unit& u, int wr, int wc, int fr, int fq) const {
        const int row0 = u.pm * BM + wr * 64 + fr, col0 = u.pn * BM + wc * 32 + 4 * fq;
#pragma unroll
        for (int ai = 0; ai < 2; ++ai)
#pragma unroll
            for (int m = 0; m < 4; ++m) { float* rowp = C + (size_t)(row0 + ai * HALF + m * 16) * ldc + col0;
#pragma unroll
                for (int bj = 0; bj < 2; ++bj)
#pragma unroll
                    for (int n = 0; n < 2; ++n) *(f32x4*)(rowp + bj * HALF + n * 16) = acc[ai][bj][m][n]; }
    }
};
struct EpiF16 {
    static constexpr bool PERM = true, AFTER_DRAIN = false;
    u16* O; int ldc; float scale0; int sctiles;
    __device__ __forceinline__ void operator()(const f32x4 (&acc)[2][2][4][2], const Unit& u, int wr, int wc, int fr, int fq) const {
        const int row0 = u.pm * BM + wr * 64 + fr, col0 = u.pn * BM + wc * 32 + 8 * fq;
        const float sc = u.pn < sctiles ? scale0 : 1.f;
#pragma unroll
        for (int ai = 0; ai < 2; ++ai)
#pragma unroll
            for (int m = 0; m < 4; ++m) { u16* rowp = O + (size_t)(row0 + ai * HALF + m * 16) * ldc + col0;
#pragma unroll
                for (int bj = 0; bj < 2; ++bj) { const f32x4 v0 = acc[ai][bj][m][0] * sc, v1 = acc[ai][bj][m][1] * sc;
                    u32x4 w; w.x = pk2h(v0[0], v0[1]); w.y = pk2h(v0[2], v0[3]); w.z = pk2h(v1[0], v1[1]); w.w = pk2h(v1[2], v1[3]);
                    *(u32x4*)(rowp + bj * HALF) = w; } }
    }
};
__device__ __forceinline__ float silu_mul(float g, float u) { return g * u * __builtin_amdgcn_rcpf(1.f + __builtin_amdgcn_exp2f(-LOG2E * g)); }
struct EpiSwiGLU {
    static constexpr bool PERM = true, AFTER_DRAIN = false;
    u16* O; int ldc;
    __device__ __forceinline__ void operator()(const f32x4 (&acc)[2][2][4][2], const Unit& u, int wr, int wc, int fr, int fq) const {
        const int row0 = u.pm * BM + wr * 64 + fr, col0 = u.pn * HALF + wc * 32 + 8 * fq;
#pragma unroll
        for (int ai = 0; ai < 2; ++ai)
#pragma unroll
            for (int m = 0; m < 4; ++m) { u16* rowp = O + (size_t)(row0 + ai * HALF + m * 16) * ldc + col0;
                const f32x4 g0 = acc[ai][0][m][0], g1 = acc[ai][0][m][1], u0 = acc[ai][1][m][0], u1 = acc[ai][1][m][1];
                u32x4 w; w.x = pk2h(silu_mul(g0[0], u0[0]), silu_mul(g0[1], u0[1])); w.y = pk2h(silu_mul(g0[2], u0[2]), silu_mul(g0[3], u0[3]));
                w.z = pk2h(silu_mul(g1[0], u1[0]), silu_mul(g1[1], u1[1])); w.w = pk2h(silu_mul(g1[2], u1[2]), silu_mul(g1[3], u1[3]));
                *(u32x4*)rowp = w; }
    }
};

template <class Epi, class Sched, bool ALIGN_EPI = false, bool SP2 = false>
__device__ __forceinline__ void gemm_phase(PG8_LAS unsigned char* lds, const Gemm g, const Sched& S, const Epi& E, const int wid) {
    const int lane = fresh_lane(), tid = wid * 64 + lane, wr = wid >> 2, wc = wid & 3, fr = lane & 15, fq = lane >> 4;
    const int K = g.K, nt = K / BK;
    unsigned voffA[2], voffB[2];
#pragma unroll
    for (int i = 0; i < 2; ++i) { int R, C; stage_rc(tid * 16 + i * 8192, R, C); const int Rb = Epi::PERM ? ((R & ~31) + perm32(R & 31)) : R;
        voffA[i] = (unsigned)(R * g.lda + C) * 2u; voffB[i] = (unsigned)(Rb * g.ldb + C) * 2u; }
    const size_t kstep = (size_t)(BK * 2);
    const size_t hstepA = (size_t)HALF * g.lda * 2, hstepB = (size_t)HALF * g.ldb * 2;
    const unsigned ldsw = (unsigned)wid * 1024u;
    const int aoff = lds_byte(wr * 64 + fr, fq * 8), boff = lds_byte(wc * 32 + fr, fq * 8);
#define PG8_SA(b, h) (((b) * 2 + (h)) * HTB)
#define PG8_SB(b, h) ((4 + (b) * 2 + (h)) * HTB)
#define PG8_STAGE(bufoff, gbase, voff) do { _Pragma("unroll") for (int _i = 0; _i < 2; ++_i) \
        __builtin_amdgcn_global_load_lds((const unsigned*)((const char*)(gbase) + (voff)[_i]), (PG8_LAS unsigned*)(lds + (bufoff) + ldsw + _i * 8192), 16, 0, 0); } while (0)
#define PG8_LDA(dst, b, h) do { _Pragma("unroll") for (int m = 0; m < 4; ++m) _Pragma("unroll") for (int k = 0; k < 2; ++k) dst[m][k] = *(const PG8_LAS h8*)(lds + PG8_SA(b, h) + aoff + m * 2048 + k * 1024); } while (0)
#define PG8_LDB(dst, b, h) do { _Pragma("unroll") for (int n = 0; n < 2; ++n) _Pragma("unroll") for (int k = 0; k < 2; ++k) dst[n][k] = *(const PG8_LAS h8*)(lds + PG8_SB(b, h) + boff + n * 2048 + k * 1024); } while (0)
#define PG8_MMA(ai, bj, At, Bt) do { __builtin_amdgcn_s_setprio(1); _Pragma("unroll") for (int m = 0; m < 4; ++m) _Pragma("unroll") for (int n = 0; n < 2; ++n) _Pragma("unroll") for (int k = 0; k < 2; ++k) \
        acc[ai][bj][m][n] = __builtin_amdgcn_mfma_f32_16x16x32_f16(Bt[n][k], At[m][k], acc[ai][bj][m][n], 0, 0, 0); __builtin_amdgcn_s_setprio(0); } while (0)
#define PG8_WAIT_V(n) asm volatile("s_waitcnt vmcnt(" #n ")" ::: "memory")
#define PG8_WAIT_L(n) asm volatile("s_waitcnt lgkmcnt(" #n ")" ::: "memory")
#define PG8_BAR __builtin_amdgcn_s_barrier()
#define PG8_SCHED __builtin_amdgcn_sched_barrier(0)
    Unit cur, nxt; int ui = 0;
    if (!S.next(0, cur)) return;
    f32x4 acc[2][2][4][2];
#pragma unroll
    for (int a = 0; a < 2; ++a)
#pragma unroll
        for (int b = 0; b < 2; ++b)
#pragma unroll
            for (int m = 0; m < 4; ++m)
#pragma unroll
                for (int n = 0; n < 2; ++n) acc[a][b][m][n] = (f32x4){0.f, 0.f, 0.f, 0.f};
    h8 At[4][2], B0[2][2], B1[2][2];
    const char* cA = cur.a; const char* cB = cur.b;
    if constexpr (SP2) {
        PG8_STAGE(PG8_SB(0, 0), cB, voffB); PG8_STAGE(PG8_SB(0, 1), cB + hstepB, voffB); PG8_STAGE(PG8_SA(0, 0), cA, voffA); PG8_STAGE(PG8_SA(0, 1), cA + hstepA, voffA);
        if (wr == 1) PG8_BAR;
        PG8_WAIT_V(2); PG8_BAR;
        PG8_STAGE(PG8_SB(1, 0), cB + kstep, voffB); PG8_STAGE(PG8_SA(1, 0), cA + kstep, voffA); PG8_STAGE(PG8_SB(1, 1), cB + hstepB + kstep, voffB);
        PG8_WAIT_V(6); PG8_BAR;
    } else {
        PG8_STAGE(PG8_SB(0, 0), cB, voffB); PG8_STAGE(PG8_SA(0, 0), cA, voffA); PG8_STAGE(PG8_SB(0, 1), cB + hstepB, voffB); PG8_STAGE(PG8_SA(0, 1), cA + hstepA, voffA);
        if (wr == 1) PG8_BAR;
        PG8_WAIT_V(4); PG8_BAR;
        PG8_STAGE(PG8_SB(1, 0), cB + kstep, voffB); PG8_STAGE(PG8_SA(1, 0), cA + kstep, voffA); PG8_STAGE(PG8_SB(1, 1), cB + hstepB + kstep, voffB);
        PG8_WAIT_V(6); PG8_BAR;
    }
    for (;;) {
        const bool has_next = S.next(ui + 1, nxt);
        const char* nA = has_next ? nxt.a : cA; const char* nB = has_next ? nxt.b : cB;
        for (int t = 0; t < nt; t += 2) {
            const bool last = (t == nt - 2);
            const char* a1 = cA + (size_t)(t + 1) * kstep;
            const char* a2 = last ? nA : cA + (size_t)(t + 2) * kstep; const char* b2 = last ? nB : cB + (size_t)(t + 2) * kstep;
            const char* a3 = a2 + kstep; const char* b3 = b2 + kstep;
            if constexpr (SP2) {
            PG8_LDB(B0, 0, 0); PG8_LDB(B1, 0, 1); PG8_SCHED; PG8_LDA(At, 0, 0); PG8_STAGE(PG8_SA(1, 1), a1 + hstepA, voffA);
            PG8_WAIT_V(8); PG8_WAIT_L(0); PG8_BAR; PG8_MMA(0, 0, At, B0); PG8_MMA(0, 1, At, B1); PG8_BAR; PG8_SCHED;
            PG8_LDA(At, 0, 1); PG8_STAGE(PG8_SB(0, 0), b2, voffB); PG8_STAGE(PG8_SB(0, 1), b2 + hstepB, voffB); PG8_STAGE(PG8_SA(0, 0), a2, voffA);
            PG8_WAIT_V(8); PG8_WAIT_L(0); PG8_BAR; PG8_MMA(1, 0, At, B0); PG8_MMA(1, 1, At, B1); PG8_BAR; PG8_SCHED;
            PG8_LDB(B0, 1, 0); PG8_LDB(B1, 1, 1); PG8_SCHED; PG8_LDA(At, 1, 0); PG8_STAGE(PG8_SA(0, 1), a2 + hstepA, voffA);
            PG8_WAIT_V(8); PG8_WAIT_L(0); PG8_BAR; PG8_MMA(0, 0, At, B0); PG8_MMA(0, 1, At, B1); PG8_BAR; PG8_SCHED;
            PG8_LDA(At, 1, 1); PG8_STAGE(PG8_SB(1, 0), b3, voffB); PG8_STAGE(PG8_SB(1, 1), b3 + hstepB, voffB); PG8_STAGE(PG8_SA(1, 0), a3, voffA);
            PG8_WAIT_V(8); PG8_WAIT_L(0); PG8_BAR; PG8_MMA(1, 0, At, B0); PG8_MMA(1, 1, At, B1); PG8_BAR; PG8_SCHED;
            } else {
            PG8_LDB(B0, 0, 0); PG8_SCHED; PG8_LDA(At, 0, 0); PG8_STAGE(PG8_SA(1, 1), a1 + hstepA, voffA);
            PG8_WAIT_L(8); PG8_BAR; PG8_WAIT_L(0); PG8_MMA(0, 0, At, B0); PG8_BAR; PG8_SCHED;
            PG8_LDB(B1, 0, 1); PG8_STAGE(PG8_SB(0, 0), b2, voffB);
            PG8_BAR; PG8_WAIT_L(0); PG8_MMA(0, 1, At, B1); PG8_BAR;
            PG8_LDA(At, 0, 1); PG8_STAGE(PG8_SA(0, 0), a2, voffA);
            PG8_BAR; PG8_WAIT_L(0); PG8_MMA(1, 0, At, B0); PG8_BAR; PG8_SCHED;
            PG8_STAGE(PG8_SB(0, 1), b2 + hstepB, voffB);
            PG8_WAIT_V(6); PG8_BAR; PG8_MMA(1, 1, At, B1); PG8_BAR;
            PG8_LDB(B0, 1, 0); PG8_SCHED; PG8_LDA(At, 1, 0); PG8_STAGE(PG8_SA(0, 1), a2 + hstepA, voffA);
            PG8_WAIT_L(8); PG8_BAR; PG8_WAIT_L(0); PG8_MMA(0, 0, At, B0); PG8_BAR; PG8_SCHED;
            PG8_LDB(B1, 1, 1); PG8_STAGE(PG8_SB(1, 0), b3, voffB);
            PG8_BAR; PG8_WAIT_L(0); PG8_MMA(0, 1, At, B1); PG8_BAR;
            PG8_LDA(At, 1, 1); PG8_STAGE(PG8_SA(1, 0), a3, voffA);
            PG8_BAR; PG8_WAIT_L(0); PG8_MMA(1, 0, At, B0); PG8_BAR; PG8_SCHED;
            PG8_STAGE(PG8_SB(1, 1), b3 + hstepB, voffB);
            PG8_WAIT_V(6); PG8_BAR; PG8_MMA(1, 1, At, B1); PG8_BAR;
            }
        }
        if constexpr (ALIGN_EPI) { if (wr == 0) PG8_BAR; }
        if constexpr (!Epi::AFTER_DRAIN) { E(acc, cur, wr, wc, fr, fq); }
        if (!has_next) break;
#pragma unroll
        for (int a = 0; a < 2; ++a)
#pragma unroll
            for (int b = 0; b < 2; ++b)
#pragma unroll
                for (int m = 0; m < 4; ++m)
#pragma unroll
                    for (int n = 0; n < 2; ++n) acc[a][b][m][n] = (f32x4){0.f, 0.f, 0.f, 0.f};
        cur = nxt; cA = nA; cB = nB; ++ui;
        if constexpr (ALIGN_EPI) { if (wr == 1) PG8_BAR; }
    }
    PG8_WAIT_V(0);
    if constexpr (!ALIGN_EPI) { if (wr == 0) PG8_BAR; }
    PG8_BAR;
    if constexpr (Epi::AFTER_DRAIN) { E.fused(acc, cur, wr, wc, fr, fq, lds, wid, lane); }
#undef PG8_SA
#undef PG8_SB
#undef PG8_STAGE
#undef PG8_LDA
#undef PG8_LDB
#undef PG8_MMA
#undef PG8_WAIT_V
#undef PG8_WAIT_L
#undef PG8_BAR
#undef PG8_SCHED
}
}

namespace moba {
typedef short s16x4 __attribute__((ext_vector_type(4)));
typedef short s16x8 __attribute__((ext_vector_type(8)));
constexpr int D = 64, PIN = DIN, POUT = DM;
constexpr int NW = 8, QBLK = 32, QB = QBLK * NW, KVBLK = 64;
__device__ __forceinline__ int crow(int r, int hi) { return (r & 3) + 8 * (r >> 2) + 4 * hi; }
#define SBAR() __builtin_amdgcn_sched_barrier(0)
__device__ __forceinline__ void cmask(f32x16& p0, f32x16& p1, int jb, int qrel, int hi) {
    const float NEG = -INFINITY; int kb = 64 * jb + 4 * hi;
#pragma unroll
    for (int r = 0; r < 16; ++r) { int kv = kb + (r & 3) + 8 * (r >> 2); if (kv > qrel) p0[r] = NEG; if (kv + 32 > qrel) p1[r] = NEG; }
}
constexpr int NSLOT = 3, SLOTB = 8192;
constexpr int LDS_K = 0, LDS_V = NSLOT * SLOTB, LDS_WS = 2 * NSLOT * SLOTB, LDS_OST = LDS_WS + NW * 64 * 4, LDS_BYTES = LDS_OST + NW * 4096;
constexpr float BIG = 60000.f;
__device__ __forceinline__ void glds16(const void* gsrc, unsigned lds_dst) { unsigned keep;
    asm volatile("s_mov_b32 %0, m0\n\ts_mov_b32 m0, %2\n\ts_nop 0\n\tglobal_load_lds_dwordx4 %1, off\n\ts_mov_b32 m0, %0" : "=&s"(keep) : "v"(gsrc), "s"(lds_dst) : "memory"); }
__device__ __forceinline__ float max3f(float a, float b, float c) { float r; asm("v_max3_f32 %0, %1, %2, %3" : "=v"(r) : "v"(a), "v"(b), "v"(c)); return r; }
__device__ __forceinline__ float max2f(float a, float b) { float r; asm("v_max_f32_e32 %0, %1, %2" : "=v"(r) : "v"(a), "v"(b)); return r; }
__device__ __forceinline__ float fadd_s(float a, float b) { float r; asm("v_add_f32_e32 %0, %1, %2" : "=v"(r) : "v"(a), "v"(b)); return r; }
__device__ __forceinline__ float fsub_s(float a, float b) { float r; asm("v_sub_f32_e32 %0, %1, %2" : "=v"(r) : "v"(a), "v"(b)); return r; }
#define WAIT_BAR(N) asm volatile("s_waitcnt vmcnt(" #N ") lgkmcnt(0)\n\ts_barrier" ::: "memory")
#define MFMA32(a, b, c) __builtin_amdgcn_mfma_f32_32x32x16_f16(a, b, c, 0, 0, 0)
__device__ __forceinline__ void qkt(f32x16& p0, f32x16& p1, const char* Kslot, const h8* qr, const f32x16& c0, const f32x16& c1, int r32, int hi) {
    const char* kb = Kslot + hi * 1024 + r32 * 16;
#pragma unroll
    for (int d0 = 0; d0 < 4; ++d0) {
        const h8 b0 = *reinterpret_cast<const h8*>(kb + d0 * 2048);
        const h8 b1 = *reinterpret_cast<const h8*>(kb + d0 * 2048 + 512);
        if (d0 == 0) { p0 = MFMA32(b0, qr[0], c0); p1 = MFMA32(b1, qr[0], c1); }
        else { p0 = MFMA32(b0, qr[d0], p0); p1 = MFMA32(b1, qr[d0], p1); } }
}
typedef __attribute__((address_space(3))) const char* lds_cptr;
typedef short v4i16_t __attribute__((ext_vector_type(4)));
#define LDSH8(p) (*(const __attribute__((address_space(3))) h8*)(p))
__device__ __forceinline__ void kload8(h8* kf, lds_cptr kp) {
    kf[0] = LDSH8(kp); kf[1] = LDSH8(kp + 512); kf[2] = LDSH8(kp + 2048); kf[3] = LDSH8(kp + 2560);
    kf[4] = LDSH8(kp + 4096); kf[5] = LDSH8(kp + 4608); kf[6] = LDSH8(kp + 6144); kf[7] = LDSH8(kp + 6656);
}
__device__ __forceinline__ void kload2(h8* kf, lds_cptr kp, int j) { kf[2 * j] = LDSH8(kp + j * 2048); kf[2 * j + 1] = LDSH8(kp + j * 2048 + 512); }
__device__ __forceinline__ s16x4 vtr(lds_cptr p) { return __builtin_bit_cast(s16x4, __builtin_amdgcn_ds_read_tr16_b64_v4i16((__attribute__((address_space(3))) v4i16_t*)p)); }
__device__ __forceinline__ h8 mk8(s16x4 lo, s16x4 hi) { s16x8 v = {lo[0], lo[1], lo[2], lo[3], hi[0], hi[1], hi[2], hi[3]}; return __builtin_bit_cast(h8, v); }
__device__ __forceinline__ float rowmax(const f32x16& p0, const f32x16& p1) {
    float a = max3f(p0[0], p0[1], p1[0]), b = max3f(p0[2], p0[3], p1[1]); a = max3f(a, p1[2], p1[3]);
#pragma unroll
    for (int r = 4; r < 16; r += 4) { a = max3f(a, p0[r], p0[r + 1]); b = max3f(b, p0[r + 2], p0[r + 3]); a = max3f(a, p1[r], p1[r + 1]); b = max3f(b, p1[r + 2], p1[r + 3]); }
    const float m = max2f(a, b);
    auto rr = __builtin_amdgcn_permlane32_swap(__float_as_uint(m), __float_as_uint(m), false, false);
    return max2f(__uint_as_float(rr[0]), __uint_as_float(rr[1]));
}
__device__ __forceinline__ void pv(f32x16* o, int vb, h8 pa0, h8 pa1, h8 pa2, h8 pa3) {
#pragma unroll
    for (int d0 = 0; d0 < 2; ++d0) { s16x4 lo[4], hi[4];
#pragma unroll
        for (int ks = 0; ks < 4; ++ks) {
            asm volatile("ds_read_b64_tr_b16 %0,%1 offset:%c2" : "=&v"(lo[ks]) : "v"(vb), "i"(d0 * 4096 + ks * 1024) : "memory");
            asm volatile("ds_read_b64_tr_b16 %0,%1 offset:%c2" : "=&v"(hi[ks]) : "v"(vb), "i"(d0 * 4096 + ks * 1024 + 512) : "memory"); }
        asm volatile("s_waitcnt lgkmcnt(0)" ::: "memory"); SBAR();
        o[d0] = MFMA32(pa0, mk8(lo[0], hi[0]), o[d0]);
        o[d0] = MFMA32(pa1, mk8(lo[1], hi[1]), o[d0]);
        o[d0] = MFMA32(pa2, mk8(lo[2], hi[2]), o[d0]);
        o[d0] = MFMA32(pa3, mk8(lo[3], hi[3]), o[d0]);
    }
}

template <int THRL> __device__ __forceinline__ void attn_unit(int b, int h, int qb, const u16* PROJ, const float* KMEAN, u16* MIX, char* shm, const int wid) {
    const int lane = fresh_lane(), r32 = lane & 31, hi = lane >> 5;
    const long rowbase = (long)b * SEQ; const int q0 = qb * QB;
    const u16* Qw = PROJ + (rowbase + q0 + wid * QBLK) * PIN + h * D;
    const u16* Kh = PROJ + rowbase * PIN + 512 + h * D; const u16* Vh = PROJ + rowbase * PIN + 1024 + h * D;
    const unsigned lds0 = (unsigned)(uintptr_t)shm;
    float* wsf = (float*)(shm + LDS_WS) + wid * 64;
    const u16* ksrc = Kh + (long)lane * PIN + wid * 8;
    const u16* vsrc = Vh + (long)(16 * (wid & 3) + (lane >> 2)) * PIN + (wid >> 2) * 32 + (lane & 3) * 8;
    const unsigned kdst = lds0 + LDS_K + wid * 1024, vdst = lds0 + LDS_V + wid * 1024;
#define KT(t) (((t) < 4) ? (4 * qb + (t)) : ((t) - 4))
#define DMA_K(t, slot) glds16(ksrc + (long)KT(t) * KVBLK * PIN, (unsigned)__builtin_amdgcn_readfirstlane(kdst + (slot)))
#define DMA_V(t, slot) glds16(vsrc + (long)KT(t) * KVBLK * PIN, (unsigned)__builtin_amdgcn_readfirstlane(vdst + (slot)))
    const int vb0 = (int)(lds0 + LDS_V) + ((lane >> 4) & 1) * 32 + (lane & 3) * 8 + (4 * hi + ((lane & 15) >> 2)) * 64;
    const char* Kbase = shm + LDS_K; h8 kf[8];
    const lds_cptr shm3 = (lds_cptr)shm; const lds_cptr kp0 = shm3 + LDS_K + hi * 1024 + r32 * 16; const lds_cptr vp0 = shm3 + LDS_V + ((lane >> 4) & 1) * 32 + (lane & 3) * 8 + (4 * hi + ((lane & 15) >> 2)) * 64;
    const int NT = 4 * (qb + 1);
    DMA_K(0, 0); DMA_V(0, 0); DMA_K(1, SLOTB);
    h8 qr[4];
#pragma unroll
    for (int d0 = 0; d0 < 4; ++d0) qr[d0] = *reinterpret_cast<const h8*>(&Qw[(long)r32 * PIN + d0 * 16 + hi * 8]);
    unsigned selmask = 0u;
    {
        const float* kmb = KMEAN + (size_t)b * NBLK * 512 + h * D + 8 * hi;
        float v1 = -INFINITY, v2 = -INFINITY, v3 = -INFINITY; int i1 = -1, i2 = -1, i3 = -1;
        for (int n = 0; n < qb; ++n) { const float* kp = kmb + n * 512; float a = 0.f;
#pragma unroll
            for (int d0 = 0; d0 < 4; ++d0) { const f32x4 x0 = *(const f32x4*)(kp + 16 * d0), x1 = *(const f32x4*)(kp + 16 * d0 + 4);
                a += (float)qr[d0][0] * x0[0] + (float)qr[d0][1] * x0[1] + (float)qr[d0][2] * x0[2] + (float)qr[d0][3] * x0[3]
                   + (float)qr[d0][4] * x1[0] + (float)qr[d0][5] * x1[1] + (float)qr[d0][6] * x1[2] + (float)qr[d0][7] * x1[3]; }
            a += __shfl_xor(a, 32);
            if (a > v1) { v3 = v2; i3 = i2; v2 = v1; i2 = i1; v1 = a; i1 = n; }
            else if (a > v2) { v3 = v2; i3 = i2; v2 = a; i2 = n; }
            else if (a > v3) { v3 = a; i3 = n; } }
        if (i1 >= 0) selmask |= 1u << i1; if (i2 >= 0) selmask |= 1u << i2; if (i3 >= 0) selmask |= 1u << i3;
    }
#define SGPRF(x) __builtin_bit_cast(float, __builtin_amdgcn_readfirstlane(__builtin_bit_cast(int, (float)(x))))
    const float slope2 = SGPRF(__builtin_amdgcn_exp2f(-(float)(h + 1)) * LOG2E), c32 = SGPRF(32.f * slope2);
    const float s1_ = slope2, s2_ = SGPRF(2.f * slope2), s3_ = SGPRF(3.f * slope2), s8_ = SGPRF(8.f * slope2), s16_ = SGPRF(16.f * slope2), s24_ = SGPRF(24.f * slope2);
    const float hi4 = hi ? 4.f * slope2 : 0.f;
    const int qrel = wid * QBLK + r32, qpos = q0 + qrel;
    float mhat = 0.f, l_reg = 0.f; f32x16 o[2]; o[0] = f32x16{}; o[1] = f32x16{};
#define CMASK(P0, P1, t) do { if ((t) < 4) cmask(P0, P1, (t), qrel, hi); } while (0)
#define CINIT(C0, C1, t) do { const bool sel_ = ((t) < 4) || (((selmask >> (((t) - 4) >> 2)) & 1u) != 0u); \
        const float base_ = (sel_ ? (slope2 * (float)(64 * KT(t) - qpos) - mhat) : -BIG) + hi4; \
        const float g0_ = base_, g1_ = base_ + s8_, g2_ = base_ + s16_, g3_ = base_ + s24_; \
        C0[0] = g0_; C0[1] = g0_ + s1_; C0[2] = g0_ + s2_; C0[3] = g0_ + s3_; C0[4] = g1_; C0[5] = g1_ + s1_; C0[6] = g1_ + s2_; C0[7] = g1_ + s3_; \
        C0[8] = g2_; C0[9] = g2_ + s1_; C0[10] = g2_ + s2_; C0[11] = g2_ + s3_; C0[12] = g3_; C0[13] = g3_ + s1_; C0[14] = g3_ + s2_; C0[15] = g3_ + s3_; \
        _Pragma("unroll") for (int r = 0; r < 16; ++r) { C1[r] = C0[r] + c32; } } while (0)
    bool resc = false;
#define START(P0, P1) do { const float rm = rowmax(P0, P1); resc = false; \
    { const float dl = rm; mhat = fadd_s(mhat, dl); \
      _Pragma("unroll") for (int r = 0; r < 16; ++r) { P0[r] = fsub_s(P0[r], dl); P1[r] = fsub_s(P1[r], dl); } } \
    _Pragma("unroll") for (int r = 0; r < 16; ++r) P0[r] = __builtin_amdgcn_exp2f(P0[r]); } while (0)
#define RESC() do { if (resc) { asm volatile("s_waitcnt lgkmcnt(0)" ::: "memory"); \
      _Pragma("unroll") for (int d_ = 0; d_ < 2; ++d_) _Pragma("unroll") for (int r = 0; r < 16; ++r) o[d_][r] *= wsf[crow(r, hi)]; } } while (0)
    f32x16 pA0, pA1, pB0, pB1;
    int sl_prev = 0, sl_cur = 0, sl_next = SLOTB;
#define ROT() do { sl_prev = sl_cur; sl_cur = sl_next; sl_next = (sl_next == (NSLOT - 1) * SLOTB) ? 0 : sl_next + SLOTB; } while (0)
    DMA_K(2, 2 * SLOTB);
    WAIT_BAR(3);
    CINIT(pB0, pB1, 0);
    qkt(pA0, pA1, Kbase, qr, pB0, pB1, r32, hi); asm volatile("s_nop 15\n\ts_nop 7" : "+v"(pA0), "+v"(pA1)); CMASK(pA0, pA1, 0);
    START(pA0, pA1);
    _Pragma("unroll") for (int r = 0; r < 16; ++r) pA1[r] = __builtin_amdgcn_exp2f(pA1[r]);
    WAIT_BAR(0);
    DMA_K(3, 0); DMA_V(1, SLOTB);
    ROT();
    kload8(kf, kp0 + sl_cur);
    WAIT_BAR(2);
    s16x4 vlo[8], vhi[8]; u32x4 pw0, pw1, pw2, pw3;
#define PKW(P, B) pk2h(P[B], P[B + 1])
#define PAF(k) __builtin_bit_cast(h8, pw##k)
#define VFR(i) mk8(vlo[i], vhi[i])
#define PINV(x) asm volatile("" : "+v"(x))
#define MX3(a, b, c) __builtin_fmaxf(__builtin_fmaxf((a), (b)), (c))
#define GAPA(MF, A0, A1, A2, A3, W0, W1, PW) do { MF; sacc += A0; sacc += A1; sacc += A2; sacc += A3; PINV(sacc); W0; W1; PINV(PW); SBAR(); } while (0)
#define EX(v) __builtin_amdgcn_exp2f(v)
#define GAPB(MF, X, B) do { MF; X[B] = EX(X[B]); X[B + 1] = EX(X[B + 1]); X[B + 2] = EX(X[B + 2]); X[B + 3] = EX(X[B + 3]); PINV(X); SBAR(); } while (0)
#define VRD(i) do { vlo[i] = vtr(vp_ + (((i) >> 2) * 4096 + ((i) & 3) * 1024)); vhi[i] = vtr(vp_ + (((i) >> 2) * 4096 + ((i) & 3) * 1024 + 512)); } while (0)
#define KRD(G, j) do { if (G) { kload2(kf, kp0 + sl_next, j); SBAR(); } } while (0)
#define STEP(C0, C1, P0, P1, t, GK, GV, GL) do { SBAR(); \
    CINIT(C0, C1, t); PINV(C0); PINV(C1); SBAR(); \
    const lds_cptr vp_ = vp0 + sl_prev; \
    VRD(0); SBAR(); float sacc = (P0[0] + P0[1]); \
    GAPA(C0 = MFMA32(kf[0], qr[0], C0), P0[2], P0[3], P0[4], P0[5],     pw0[0] = PKW(P0, 0), pw0[1] = PKW(P0, 2), pw0); \
    VRD(4); SBAR(); GAPA(C1 = MFMA32(kf[1], qr[0], C1), P0[6], P0[7], P0[8], P0[9],     pw0[2] = PKW(P0, 4), pw0[3] = PKW(P0, 6), pw0); \
    VRD(1); SBAR(); GAPA(C0 = MFMA32(kf[2], qr[1], C0),   P0[10], P0[11], P0[12], P0[13], pw1[0] = PKW(P0, 8), pw1[1] = PKW(P0, 10), pw1); \
    VRD(5); SBAR(); GAPA(C1 = MFMA32(kf[3], qr[1], C1),   P0[14], P0[15], P1[0], P1[1],   pw1[2] = PKW(P0, 12), pw1[3] = PKW(P0, 14), pw1); \
    VRD(2); SBAR(); GAPA(C0 = MFMA32(kf[4], qr[2], C0),   P1[2], P1[3], P1[4], P1[5],     pw2[0] = PKW(P1, 0), pw2[1] = PKW(P1, 2), pw2); \
    VRD(6); SBAR(); GAPA(C1 = MFMA32(kf[5], qr[2], C1),   P1[6], P1[7], P1[8], P1[9],     pw2[2] = PKW(P1, 4), pw2[3] = PKW(P1, 6), pw2); \
    VRD(3); SBAR(); GAPA(C0 = MFMA32(kf[6], qr[3], C0),   P1[10], P1[11], P1[12], P1[13], pw3[0] = PKW(P1, 8), pw3[1] = PKW(P1, 10), pw3); \
    VRD(7); SBAR(); GAPA(C1 = MFMA32(kf[7], qr[3], C1),   P1[14], P1[15], 0.f, 0.f,       pw3[2] = PKW(P1, 12), pw3[3] = PKW(P1, 14), pw3); \
    l_reg += sacc; \
    if (GK) { DMA_K((t) + 3, sl_cur); } if (GV) { DMA_V((t) + 1, sl_next); } \
    CMASK(C0, C1, t); \
    { float a = MX3(C0[0], C0[1], C1[0]), b_ = MX3(C0[2], C0[3], C1[1]); a = MX3(a, C1[2], C1[3]); \
      _Pragma("unroll") for (int r = 4; r < 16; r += 4) { a = MX3(a, C0[r], C0[r + 1]); b_ = MX3(b_, C0[r + 2], C0[r + 3]); a = MX3(a, C1[r], C1[r + 1]); b_ = MX3(b_, C1[r + 2], C1[r + 3]); } \
      float rm = __builtin_fmaxf(a, b_); { auto rr = __builtin_amdgcn_permlane32_swap(__float_as_uint(rm), __float_as_uint(rm), false, false); rm = __builtin_fmaxf(__uint_as_float(rr[0]), __uint_as_float(rr[1])); } \
      resc = false; \
      if (__builtin_expect(__any(rm > (float)THRL), 0)) { const float dl = __builtin_fmaxf(rm, 0.f); mhat += dl; \
        _Pragma("unroll") for (int r = 0; r < 16; ++r) { C0[r] -= dl; C1[r] -= dl; } \
        const float f = __builtin_amdgcn_exp2f(-dl); l_reg *= f; if (hi == 0) wsf[r32] = f; resc = true; } } \
    SBAR(); \
    GAPB(o[0] = MFMA32(PAF(0), VFR(0), o[0]), C0, 0); \
    GAPB(o[1] = MFMA32(PAF(0), VFR(4), o[1]), C0, 4); \
    KRD(GL, 0); GAPB(o[0] = MFMA32(PAF(1), VFR(1), o[0]), C0, 8); \
    KRD(GL, 1); GAPB(o[1] = MFMA32(PAF(1), VFR(5), o[1]), C0, 12); \
    KRD(GL, 2); GAPB(o[0] = MFMA32(PAF(2), VFR(2), o[0]), C1, 0); \
    KRD(GL, 3); GAPB(o[1] = MFMA32(PAF(2), VFR(6), o[1]), C1, 4); \
    GAPB(o[0] = MFMA32(PAF(3), VFR(3), o[0]), C1, 8); \
    GAPB(o[1] = MFMA32(PAF(3), VFR(7), o[1]), C1, 12); \
    } while (0)
#define ENDW(tt) do { if ((tt) + 3 < NT) { WAIT_BAR(2); } else if ((tt) + 2 < NT) { WAIT_BAR(1); } else { WAIT_BAR(0); } } while (0)
    int t = 1;
    for (; t + 1 < NT; t += 2) {
        STEP(pB0, pB1, pA0, pA1, t, (t + 3 < NT), (t + 1 < NT), (t + 1 < NT));       ENDW(t);     RESC(); ROT();
        STEP(pA0, pA1, pB0, pB1, t + 1, (t + 4 < NT), (t + 2 < NT), (t + 2 < NT));   ENDW(t + 1); RESC(); ROT();
    }
    STEP(pB0, pB1, pA0, pA1, NT - 1, false, false, false); RESC();
    { float sacc = pB0[0] + pB0[1]; _Pragma("unroll") for (int r = 2; r < 16; ++r) sacc += pB0[r]; _Pragma("unroll") for (int r = 0; r < 16; ++r) sacc += pB1[r]; l_reg += sacc;
      pw0 = (u32x4){PKW(pB0, 0), PKW(pB0, 2), PKW(pB0, 4), PKW(pB0, 6)}; pw1 = (u32x4){PKW(pB0, 8), PKW(pB0, 10), PKW(pB0, 12), PKW(pB0, 14)};
      pw2 = (u32x4){PKW(pB1, 0), PKW(pB1, 2), PKW(pB1, 4), PKW(pB1, 6)}; pw3 = (u32x4){PKW(pB1, 8), PKW(pB1, 10), PKW(pB1, 12), PKW(pB1, 14)};
      SBAR(); pv(o, vb0 + sl_cur, PAF(0), PAF(1), PAF(2), PAF(3)); }
    { auto rr = __builtin_amdgcn_permlane32_swap(__float_as_uint(l_reg), __float_as_uint(l_reg), false, false); l_reg = __uint_as_float(rr[0]) + __uint_as_float(rr[1]); }
    if (hi == 0) wsf[32 + r32] = l_reg; asm volatile("s_waitcnt lgkmcnt(0)" ::: "memory");
    float rli[16];
#pragma unroll
    for (int r = 0; r < 16; ++r) rli[r] = __builtin_amdgcn_rcpf(wsf[32 + crow(r, hi)]);
    u16* Ow = MIX + (rowbase + q0 + wid * QBLK) * POUT + h * D;
    { u16* stg = (u16*)(shm + LDS_OST) + wid * 2048;
#pragma unroll
      for (int r = 0; r < 16; ++r) { const int orow = crow(r, hi);
#pragma unroll
        for (int d0 = 0; d0 < 2; ++d0) stg[orow * 64 + d0 * 32 + r32] = f2h(o[d0][r] * rli[r]); }
      asm volatile("s_waitcnt lgkmcnt(0)" ::: "memory");
#pragma unroll
      for (int i = 0; i < 4; ++i) { const int row = i * 8 + (lane >> 3), ch = lane & 7; const u32x4 v = *(const u32x4*)(stg + row * 64 + ch * 8); *(u32x4*)(Ow + (long)row * POUT + ch * 8) = v; } }
    asm volatile("s_waitcnt lgkmcnt(0)\n\ts_barrier" ::: "memory");
#undef SGPRF
#undef KT
#undef DMA_K
#undef DMA_V
#undef CMASK
#undef CINIT
#undef START
#undef RESC
#undef ROT
#undef PKW
#undef PAF
#undef VFR
#undef PINV
#undef MX3
#undef GAPA
#undef GAPB
#undef EX
#undef VRD
#undef KRD
#undef STEP
#undef ENDW
}
#undef SBAR
#undef WAIT_BAR
#undef MFMA32
#undef LDSH8
}

namespace cg = cooperative_groups;
constexpr int NWAVES = 8, NTHREADS = NWAVES * 64;
constexpr int LDS_BYTES = 147456;
struct Args { Ptrs p; };

__global__ void __launch_bounds__(NTHREADS, 2) mega(Args args) {
    extern __shared__ __attribute__((aligned(16))) unsigned char lds[];
    cg::grid_group grid = cg::this_grid();
    const Ptrs& P = args.p;
    unsigned char* ws = P.ws;
    const int wave = __builtin_amdgcn_readfirstlane((int)threadIdx.x >> 6);
#define lane fresh_lane()
    const int G = gridDim.x, gw = blockIdx.x * NWAVES + wave, NGW = G * NWAVES;
    float* wl = (float*)(lds + wave * 16384);
    u16 *XN = (u16*)(ws + WS_XN), *ACT = (u16*)(ws + WS_ACT), *PROJ = (u16*)(ws + WS_PROJ), *MIX = (u16*)(ws + WS_MIX), *XQ = (u16*)(ws + WS_XQ), *XAO = (u16*)(ws + WS_XAO);
    u16 *MEMN = (u16*)(ws + WS_MEMN), *KMEM = (u16*)(ws + WS_KMEM), *VMEMT = (u16*)(ws + WS_VMEMT);
    float *F32A = (float*)(ws + WS_F32A), *F32B = (float*)(ws + WS_F32B), *KMEAN = (float*)(ws + WS_KMEAN), *OUT = P.out;
#define GSYNC() grid.sync()
    PG8_LAS unsigned char* ldsl = (PG8_LAS unsigned char*)lds;
#define DENSE(EPI, epi, Aptr, lda_, Btptr, ldb_, nM_, nN_, K_, ALIGN) do { pg8::DenseOrder S_; S_.init(nM_, nN_, G, (int)blockIdx.x); S_.A = (Aptr); S_.Bt = (Btptr); S_.lda = (lda_); S_.ldb = (ldb_); \
        pg8::gemm_phase<EPI, pg8::DenseOrder, ALIGN, true>(ldsl, pg8::Gemm{K_, lda_, ldb_}, S_, epi, wave); } while (0)
    prologue(P, gw, NGW, lane, wl);
    GSYNC();
    { pg8::EpiSwiGLU e{ACT, DFF}; DENSE(pg8::EpiSwiGLU, e, XN, DM, (u16*)(ws + WS_W1A), DM, M / 256, 2 * DFF / 256, DM, true); }
    { pg8::EpiF16 e{KMEM, DM, 1.f, 0}; DENSE(pg8::EpiF16, e, MEMN, DM, (u16*)(ws + WS_WKV), DM, BATCH * NMEM / 256, DM / 256, DM, true); }
    for (int b = 0; b < BATCH; ++b) { pg8::EpiF16 e{VMEMT + (size_t)b * DM * NMEM, NMEM, 1.f, 0}; DENSE(pg8::EpiF16, e, (u16*)(ws + WS_WKV) + (size_t)DM * DM, DM, MEMN + (size_t)b * NMEM * DM, DM, DM / 256, NMEM / 256, DM, true); }
    GSYNC();
    { pg8::EpiF32 e{F32A, DM}; DENSE(pg8::EpiF32, e, ACT, DFF, (u16*)(ws + WS_W1D), DFF, M / 256, DM / 256, DFF, false); }
    GSYNC();
    nv_rownorm(gw, NGW, lane, F32A, P.in[0], 0.5f, P.in[6], OUT, P.in[7], XN);
    GSYNC();
    { pg8::EpiF16 e{PROJ, DIN, QSCALE, 2}; DENSE(pg8::EpiF16, e, XN, DM, (u16*)(ws + WS_WIN), DM, M / 256, DIN / 256, DM, true); }
    GSYNC();
    nv_kmean(gw, NGW, lane, PROJ, KMEAN);
    GSYNC();
    { const int vcu = ((int)blockIdx.x % 8) * (G / 8) + (int)blockIdx.x / 8, bh = vcu >> 3, sidx = vcu & 7;
      static_assert(moba::LDS_BYTES <= 131072, "attention LDS");
      moba::attn_unit<8>(bh / NH, bh % NH, sidx, PROJ, KMEAN, MIX, (char*)lds, wave);
      moba::attn_unit<8>(bh / NH, bh % NH, 15 - sidx, PROJ, KMEAN, MIX, (char*)lds, wave); }
    nv_pool(gw, NGW, lane, wl, PROJ, P.in[9], P.in[10], MIX);
    GSYNC();
    { pg8::EpiF32 e{F32B, DM}; DENSE(pg8::EpiF32, e, MIX, DM, (u16*)(ws + WS_WOUT), DM, M / 256, DM / 256, DM, false); }
    GSYNC();
    nv_rownorm(gw, NGW, lane, F32B, OUT, 1.0f, P.in[12], OUT, P.in[13], XN);
    GSYNC();
    { pg8::EpiF16 e{XQ, DM, XQSCALE, 4}; DENSE(pg8::EpiF16, e, XN, DM, (u16*)(ws + WS_WQ), DM, M / 256, DM / 256, DM, false); }
    GSYNC();
    nv_xattn(gw, NGW, lane, wl, XQ, KMEM, VMEMT, XAO);
    GSYNC();
    { pg8::EpiF32 e{F32B, DM}; DENSE(pg8::EpiF32, e, XAO, DM, (u16*)(ws + WS_WO), DM, M / 256, DM / 256, DM, false); }
    GSYNC();
    nv_rownorm(gw, NGW, lane, F32B, OUT, 1.0f, P.in[18], OUT, P.in[19], XN);
    GSYNC();
    { pg8::EpiSwiGLU e{ACT, DFF}; DENSE(pg8::EpiSwiGLU, e, XN, DM, (u16*)(ws + WS_W2A), DM, M / 256, 2 * DFF / 256, DM, true); }
    GSYNC();
    { pg8::EpiF32 e{F32A, DM}; DENSE(pg8::EpiF32, e, ACT, DFF, (u16*)(ws + WS_W2D), DFF, M / 256, DM / 256, DFF, false); }
    GSYNC();
    nv_rownorm(gw, NGW, lane, F32A, OUT, 0.5f, P.in[23], OUT, nullptr, nullptr);
#undef lane
}

extern "C" void kernel_launch(void* const* d_in, const int* in_sizes, int n_in, void* d_out, int out_size, void* d_ws, size_t ws_size, hipStream_t stream) {
    static int grid = 0;
    if (grid == 0) {
        if (n_in != 24 || out_size != M * DM || ws_size < WS_END) { fprintf(stderr, "kernel_launch: unexpected shapes (n_in %d out %d ws %zu)\n", n_in, out_size, ws_size); grid = -1; return; }
        int dev = 0, cus = 0, per_cu = 0;
        if (hipGetDevice(&dev) != hipSuccess || hipDeviceGetAttribute(&cus, hipDeviceAttributeMultiprocessorCount, dev) != hipSuccess) { grid = -1; return; }
        if (hipFuncSetAttribute((const void*)mega, hipFuncAttributeMaxDynamicSharedMemorySize, LDS_BYTES) != hipSuccess) { fprintf(stderr, "kernel_launch: hipFuncSetAttribute failed\n"); grid = -1; return; }
        if (hipOccupancyMaxActiveBlocksPerMultiprocessor(&per_cu, (const void*)mega, NTHREADS, LDS_BYTES) != hipSuccess || per_cu < 1) { fprintf(stderr, "kernel_launch: occupancy query failed (%d)\n", per_cu); grid = -1; return; }
        grid = cus * 1;
        fprintf(stderr, "kernel_launch: %d CUs, occupancy %d/CU, grid %d\n", cus, per_cu, grid);
    }
    if (grid < 0) return;
    (void)hipMemsetAsync((unsigned char*)d_ws + WS_CTL, 0, CTL_BYTES, stream);
    Args a{};
    for (int i = 0; i < 24; ++i) a.p.in[i] = (const float*)d_in[i];
    a.p.out = (float*)d_out; a.p.ws = (unsigned char*)d_ws;
    void* kargs[] = {&a};
    hipError_t e = hipLaunchCooperativeKernel((const void*)mega, dim3(grid), dim3(NTHREADS), kargs, LDS_BYTES, stream);
    if (e != hipSuccess) fprintf(stderr, "kernel_launch: cooperative launch failed: %s (grid %d)\n", hipGetErrorString(e), grid);
}
```

```cpp
#include <hip/hip_runtime.h>
#include <hip/hip_cooperative_groups.h>
#include <cstdio>
#include <cstdint>

typedef unsigned short u16;
typedef _Float16 h8 __attribute__((ext_vector_type(8)));
typedef _Float16 h2 __attribute__((ext_vector_type(2)));
typedef float f32x2 __attribute__((ext_vector_type(2)));
typedef float f32x4 __attribute__((ext_vector_type(4)));
typedef float f32x16 __attribute__((ext_vector_type(16)));
typedef unsigned u32x4 __attribute__((ext_vector_type(4)));
typedef unsigned u32x2 __attribute__((ext_vector_type(2)));

constexpr int BATCH = 4, SEQ = 4096, DM = 1024, M = BATCH * SEQ;
constexpr int NH = 8, HD = 64, DATT = 512, DPOOL = 512, DIN = 2048;
constexpr int LBLK = 256, NBLK = SEQ / LBLK;
constexpr int NMEM = 256, XH = 4, XHD = 256;
constexpr int DFF = 2816;
constexpr float EPS = 1e-6f;
constexpr float LOG2E = 1.4426950408889634f;
constexpr float QSCALE = 0.125f * LOG2E;
constexpr float XQSCALE = 0.0625f * LOG2E;

constexpr size_t MiB = 1u << 20;
constexpr size_t WS_CTL = 0, CTL_BYTES = 1 * MiB;
constexpr size_t WS_KMEAN = 1 * MiB;
constexpr size_t WS_XBUF = 2 * MiB;
constexpr size_t WS_MEMN = 5 * MiB;
constexpr size_t WS_KMEM = 7 * MiB;
constexpr size_t WS_VMEMT = 9 * MiB;
constexpr size_t WS_WPT = 11 * MiB;
constexpr size_t WS_W1A = 12 * MiB;
constexpr size_t WS_W1D = 23 * MiB;
constexpr size_t WS_W2A = WS_W1D + 5 * MiB + MiB / 2;
constexpr size_t WS_W2D = WS_W2A + 11 * MiB;
constexpr size_t WS_WIN = 45 * MiB;
constexpr size_t WS_WOUT = 49 * MiB;
constexpr size_t WS_WQ = 51 * MiB;
constexpr size_t WS_WKV = 53 * MiB;
constexpr size_t WS_WO = 57 * MiB;
constexpr size_t WS_XN = 60 * MiB;
constexpr size_t WS_R1 = 92 * MiB;
constexpr size_t WS_ACT = WS_R1, WS_PROJ = WS_R1, WS_XQ = WS_R1, WS_XP = WS_R1 + 32 * MiB, WS_F32B = WS_R1;
constexpr size_t WS_R2 = 180 * MiB;
constexpr size_t WS_MIX = WS_R2, WS_XAO = WS_R2 + 32 * MiB, WS_F32A = WS_R2;
constexpr size_t WS_END = 244 * MiB;

__device__ __forceinline__ float h2f(u16 v) { return (float)__builtin_bit_cast(_Float16, v); }
__device__ __forceinline__ u16 f2h(float f) { return __builtin_bit_cast(u16, (_Float16)f); }
__device__ __forceinline__ unsigned pk2h(float lo, float hi) { f32x2 v = {lo, hi}; h2 h = __builtin_convertvector(v, h2); return __builtin_bit_cast(unsigned, h); }
__device__ __forceinline__ float wave_sum(float v) {
#pragma unroll
    for (int o = 1; o < 64; o <<= 1) v += __shfl_xor(v, o);
    return v;
}
__device__ __forceinline__ float wave_max(float v) {
#pragma unroll
    for (int o = 1; o < 64; o <<= 1) v = fmaxf(v, __shfl_xor(v, o));
    return v;
}

__device__ __forceinline__ int fresh_lane() { int l; asm volatile("v_mbcnt_lo_u32_b32 %0, -1, 0\n\tv_mbcnt_hi_u32_b32 %0, -1, %0" : "=v"(l)); return l; }

struct Ptrs {
    const float* in[24];
    float* out;
    unsigned char* ws;
};

__device__ __forceinline__ int rowmap(int map, int n) { return map == 0 ? n : ((n >> 7) * 256 + (map == 2 ? 128 : 0) + (n & 127)); }
__device__ __forceinline__ void transpose_item(const float* W, int K, int N, u16* WT, int map, float* scr, int item, int lane) {
    const int nblk = N / 32, kb = item / nblk, nb = item % nblk, k0 = 64 * kb, n0 = 32 * nb;
#pragma unroll 8
    for (int i = 0; i < 32; ++i) { const int kk = 2 * i + (lane >> 5); scr[kk * 33 + (lane & 31)] = W[(size_t)(k0 + kk) * N + n0 + (lane & 31)]; }
    asm volatile("s_waitcnt lgkmcnt(0)" ::: "memory");
    const int c = lane & 7;
    const int r0 = rowmap(map, n0);
#pragma unroll
    for (int j = 0; j < 4; ++j) { const int n = (lane >> 3) + 8 * j; const float* s = scr + (8 * c) * 33 + n;
        u32x4 o; o.x = pk2h(s[0 * 33], s[1 * 33]); o.y = pk2h(s[2 * 33], s[3 * 33]); o.z = pk2h(s[4 * 33], s[5 * 33]); o.w = pk2h(s[6 * 33], s[7 * 33]);
        *(u32x4*)(WT + (size_t)(r0 + n) * K + k0 + 8 * c) = o; }
    asm volatile("s_waitcnt lgkmcnt(0)" ::: "memory");
}
__device__ __forceinline__ void rms_row_to_f16(const float* xrow, const float* g, u16* orow, int lane) {
    const f32x4* xr = (const f32x4*)xrow + lane; const f32x4* gr = (const f32x4*)g + lane;
    f32x4 v[4]; float s = 0.f;
#pragma unroll
    for (int j = 0; j < 4; ++j) { v[j] = xr[64 * j]; s += (v[j].x * v[j].x + v[j].y * v[j].y) + (v[j].z * v[j].z + v[j].w * v[j].w); }
    const float r = 1.0f / sqrtf(wave_sum(s) * (1.f / DM) + EPS);
    u32x2* o8 = (u32x2*)orow + lane;
#pragma unroll
    for (int j = 0; j < 4; ++j) { const f32x4 gg = gr[64 * j]; u32x2 w; w.x = pk2h(v[j].x * r * gg.x, v[j].y * r * gg.y); w.y = pk2h(v[j].z * r * gg.z, v[j].w * r * gg.w); o8[64 * j] = w; }
}
struct TItem { int idx, K, N; size_t dst; int map; };
__device__ __forceinline__ void prologue(const Ptrs& P, int gw, int NGW, int lane, float* scr) {
    unsigned char* ws = P.ws;
    constexpr int I_UP = 16 * 88, I_DN = 44 * 32, I_IN = 16 * 64, I_SQ = 16 * 32, I_PW = 8 * 4;
    constexpr int NITEMS = 4 * I_UP + 2 * I_DN + 2 * I_IN + 3 * I_SQ + I_PW;
    for (int it = gw; it < NITEMS; it += NGW) {
        int r = it;
        if (r < I_UP) { transpose_item(P.in[3], 1024, DFF, (u16*)(ws + WS_W1A), 1, scr, r, lane); continue; } r -= I_UP;
        if (r < I_UP) { transpose_item(P.in[4], 1024, DFF, (u16*)(ws + WS_W1A), 2, scr, r, lane); continue; } r -= I_UP;
        if (r < I_DN) { transpose_item(P.in[5], DFF, 1024, (u16*)(ws + WS_W1D), 0, scr, r, lane); continue; } r -= I_DN;
        if (r < I_UP) { transpose_item(P.in[20], 1024, DFF, (u16*)(ws + WS_W2A), 1, scr, r, lane); continue; } r -= I_UP;
        if (r < I_UP) { transpose_item(P.in[21], 1024, DFF, (u16*)(ws + WS_W2A), 2, scr, r, lane); continue; } r -= I_UP;
        if (r < I_DN) { transpose_item(P.in[22], DFF, 1024, (u16*)(ws + WS_W2D), 0, scr, r, lane); continue; } r -= I_DN;
        if (r < I_IN) { transpose_item(P.in[8], 1024, DIN, (u16*)(ws + WS_WIN), 0, scr, r, lane); continue; } r -= I_IN;
        if (r < I_IN) { transpose_item(P.in[16], 1024, 2048, (u16*)(ws + WS_WKV), 0, scr, r, lane); continue; } r -= I_IN;
        if (r < I_SQ) { transpose_item(P.in[11], 1024, 1024, (u16*)(ws + WS_WOUT), 0, scr, r, lane); continue; } r -= I_SQ;
        if (r < I_SQ) { transpose_item(P.in[15], 1024, 1024, (u16*)(ws + WS_WQ), 0, scr, r, lane); continue; } r -= I_SQ;
        if (r < I_SQ) { transpose_item(P.in[17], 1024, 1024, (u16*)(ws + WS_WO), 0, scr, r, lane); continue; } r -= I_SQ;
        transpose_item(P.in[9], 512, 128, (u16*)(ws + WS_WPT), 0, scr, r, lane);
    }
    for (int m = gw; m < M; m += NGW) rms_row_to_f16(P.in[0] + (size_t)m * DM, P.in[2], (u16*)(ws + WS_XN) + (size_t)m * DM, lane);
    for (int m = gw; m < BATCH * NMEM; m += NGW) rms_row_to_f16(P.in[1] + (size_t)m * DM, P.in[14], (u16*)(ws + WS_MEMN) + (size_t)m * DM, lane);
    float* km = (float*)(ws + WS_KMEAN);
    for (int i = gw * 64 + lane; i < BATCH * NBLK * 512; i += NGW * 64) km[i] = 0.f;
}

template <int MODE>
__device__ __forceinline__ void nv_gemm(int gw, int NGW, int lane, const u16* A, int lda, const u16* Bt, int ldb, int Mr, int N, int K, void* C, int ldc, float sc, int sccols) {
    const int r = lane & 31, h = lane >> 5, ntn = N / 32, ntiles = (Mr / 32) * ntn;
    for (int wt = gw; wt < ntiles; wt += NGW) {
        const int m0 = (wt / ntn) * 32, n0 = (wt % ntn) * 32;
        const u16* ap = A + (size_t)(m0 + r) * lda + 8 * h;
        if (MODE == 2) {
            const int rg = (n0 >> 7) * 256 + (n0 & 127), ru = rg + 128;
            f32x16 ag = {}, au = {};
            const u16* bg = Bt + (size_t)(rg + r) * ldb + 8 * h;
            const u16* bu = Bt + (size_t)(ru + r) * ldb + 8 * h;
            for (int k = 0; k < K; k += 16) {
                const h8 a = *(const h8*)(ap + k), g = *(const h8*)(bg + k), u = *(const h8*)(bu + k);
                ag = __builtin_amdgcn_mfma_f32_32x32x16_f16(a, g, ag, 0, 0, 0);
                au = __builtin_amdgcn_mfma_f32_32x32x16_f16(a, u, au, 0, 0, 0);
            }
#pragma unroll
            for (int i = 0; i < 16; ++i) { const int row = m0 + (i & 3) + 8 * (i >> 2) + 4 * h, col = n0 + r;
                const float gv = ag[i], uv = au[i]; const float sg = gv / (1.f + __expf(-gv));
                ((u16*)C)[(size_t)row * ldc + col] = f2h(sg * uv); }
        } else {
            f32x16 acc = {};
            const u16* bp = Bt + (size_t)(n0 + r) * ldb + 8 * h;
            for (int k = 0; k < K; k += 16) {
                const h8 a = *(const h8*)(ap + k), b = *(const h8*)(bp + k);
                acc = __builtin_amdgcn_mfma_f32_32x32x16_f16(a, b, acc, 0, 0, 0);
            }
#pragma unroll
            for (int i = 0; i < 16; ++i) { const int row = m0 + (i & 3) + 8 * (i >> 2) + 4 * h, col = n0 + r;
                if (MODE == 0) ((u16*)C)[(size_t)row * ldc + col] = f2h(acc[i] * (col < sccols ? sc : 1.f));
                else ((float*)C)[(size_t)row * ldc + col] = acc[i]; }
        }
    }
}
__device__ __forceinline__ void nv_rownorm(int gw, int NGW, int lane, const float* F, const float* base, float w, const float* gpost, float* out, const float* gnext, u16* XN) {
    for (int row = gw; row < M; row += NGW) {
        const f32x4* fr = (const f32x4*)(F + (size_t)row * DM) + lane; const f32x4* br = (const f32x4*)(base + (size_t)row * DM) + lane;
        const f32x4* gp = (const f32x4*)gpost + lane;
        f32x4 f[4], x[4]; float s = 0.f;
#pragma unroll
        for (int j = 0; j < 4; ++j) { f[j] = fr[64 * j]; x[j] = br[64 * j]; s += (f[j].x * f[j].x + f[j].y * f[j].y) + (f[j].z * f[j].z + f[j].w * f[j].w); }
        const float r = 1.0f / sqrtf(wave_sum(s) * (1.f / DM) + EPS);
        float s2 = 0.f;
#pragma unroll
        for (int j = 0; j < 4; ++j) { const f32x4 g = gp[64 * j]; x[j] = x[j] + w * ((f[j] * r) * g); s2 += (x[j].x * x[j].x + x[j].y * x[j].y) + (x[j].z * x[j].z + x[j].w * x[j].w); }
        f32x4* orow = (f32x4*)(out + (size_t)row * DM) + lane;
#pragma unroll
        for (int j = 0; j < 4; ++j) orow[64 * j] = x[j];
        if (XN) {
            const float r2 = 1.0f / sqrtf(wave_sum(s2) * (1.f / DM) + EPS);
            const f32x4* gn = (const f32x4*)gnext + lane; u32x2* o8 = (u32x2*)(XN + (size_t)row * DM) + lane;
#pragma unroll
            for (int j = 0; j < 4; ++j) { const f32x4 g = gn[64 * j]; u32x2 o; o.x = pk2h(x[j].x * r2 * g.x, x[j].y * r2 * g.y); o.y = pk2h(x[j].z * r2 * g.z, x[j].w * r2 * g.w); o8[64 * j] = o; }
        }
    }
}
__device__ __forceinline__ void nv_kmean(int gw, int NGW, int lane, const u16* PROJ, float* KMEAN) {
    for (int i = gw * 64 + lane; i < BATCH * NBLK * 512; i += NGW * 64) { const int bb = i >> 9, c = i & 511; float s = 0.f;
        for (int r = 0; r < LBLK; ++r) s += h2f(PROJ[(size_t)(bb * LBLK + r) * DIN + 512 + c]);
        KMEAN[i] = s * (1.f / LBLK); }
}
__device__ __forceinline__ void nv_moba(int gw, int NGW, int lane, float* wl, const u16* PROJ, const float* KMEAN, u16* MIX) {
    float* sq = wl; float* sp = wl + 64;
    for (int gq = gw; gq < BATCH * NH * SEQ; gq += NGW) {
        const int t = gq % SEQ, h = (gq / SEQ) % NH, b = gq / (SEQ * NH);
        const size_t row = (size_t)b * SEQ + t;
        const int own = t / LBLK;
        const float qd = h2f(PROJ[row * DIN + h * HD + lane]);
        sq[lane] = qd;
        float v1 = -INFINITY, v2 = -INFINITY, v3 = -INFINITY; int i1 = -1, i2 = -1, i3 = -1;
        for (int n = 0; n < own; ++n) {
            const float g = wave_sum(qd * KMEAN[((size_t)b * NBLK + n) * 512 + h * HD + lane]);
            if (g > v1) { v3 = v2; i3 = i2; v2 = v1; i2 = i1; v1 = g; i1 = n; }
            else if (g > v2) { v3 = v2; i3 = i2; v2 = g; i2 = n; }
            else if (g > v3) { v3 = g; i3 = n; }
        }
        const float slope2 = exp2f(-(float)(h + 1)) * LOG2E;
        int blks[4] = {i1, i2, i3, own};
        float s[16]; float mx = -INFINITY;
#pragma unroll
        for (int sl = 0; sl < 4; ++sl) {
            const int blk = blks[sl];
#pragma unroll
            for (int c = 0; c < 4; ++c) {
                float sc = -INFINITY;
                if (blk >= 0) {
                    const int kpos = blk * LBLK + c * 64 + lane;
                    if (kpos <= t) {
                        const u16* kr = PROJ + ((size_t)b * SEQ + kpos) * DIN + 512 + h * HD; float a = 0.f;
#pragma unroll 2
                        for (int d = 0; d < 64; d += 8) { const h8 kv = *(const h8*)(kr + d);
#pragma unroll
                            for (int j = 0; j < 8; ++j) a += sq[d + j] * (float)kv[j]; }
                        sc = a - slope2 * (float)(t - kpos);
                    }
                }
                s[sl * 4 + c] = sc; mx = fmaxf(mx, sc);
            }
        }
        mx = wave_max(mx);
        float l = 0.f;
#pragma unroll
        for (int i = 0; i < 16; ++i) { const float p = exp2f(s[i] - mx); l += p; sp[i * 64 + lane] = p; }
        l = wave_sum(l);
        float o = 0.f;
#pragma unroll
        for (int sl = 0; sl < 4; ++sl) {
            const int blk = blks[sl];
            if (blk >= 0) {
                const u16* vb = PROJ + ((size_t)b * SEQ + blk * LBLK) * DIN + 1024 + h * HD + lane;
                for (int j = 0; j < LBLK; ++j) o += sp[sl * 256 + j] * h2f(vb[(size_t)j * DIN]);
            }
        }
        MIX[row * DM + h * HD + lane] = f2h(o / l);
    }
}
__device__ __forceinline__ void nv_pool(int gw, int NGW, int lane, float* wl, const u16* PROJ, const float* pool_w, const float* pool_scale, u16* MIX) {
    for (int it = gw; it < M * 4; it += NGW) {
        const int g = it & 3; const size_t row = it >> 2; const int t = (int)(row % SEQ);
        const int w = 2 << g, lo = max(t + 1 - w, 0), cnt = t + 1 - lo;
#pragma unroll
        for (int hh = 0; hh < 2; ++hh) { const int c = lane + 64 * hh; float s = 0.f;
            for (int j = lo; j <= t; ++j) s += h2f(PROJ[(row - (t - j)) * DIN + 1536 + g * 128 + c]);
            wl[c] = s / (float)cnt - h2f(PROJ[row * DIN + 1536 + g * 128 + c]); }
        float y0 = 0.f, y1 = 0.f;
        for (int k = 0; k < 128; ++k) { const float d = wl[k]; y0 += d * pool_w[((size_t)g * 128 + k) * 128 + lane]; y1 += d * pool_w[((size_t)g * 128 + k) * 128 + lane + 64]; }
        MIX[row * DM + 512 + g * 128 + lane] = f2h(y0 * pool_scale[g * 128 + lane]);
        MIX[row * DM + 512 + g * 128 + lane + 64] = f2h(y1 * pool_scale[g * 128 + lane + 64]);
    }
}
__device__ __forceinline__ void nv_xattn(int gw, int NGW, int lane, float* wl, const u16* XQ, const u16* KMEM, const u16* VMEMT, u16* XAO) {
    float* sq = wl; float* sp = wl + 256;
    for (int gi = gw; gi < M * XH; gi += NGW) {
        const int h = gi & 3; const size_t row = gi >> 2; const int b = (int)(row / SEQ);
#pragma unroll
        for (int j = 0; j < 4; ++j) sq[j * 64 + lane] = h2f(XQ[row * DM + h * XHD + j * 64 + lane]);
        float s[4]; float mx = -INFINITY;
#pragma unroll
        for (int j = 0; j < 4; ++j) { const int m = j * 64 + lane; const u16* kr = KMEM + ((size_t)b * NMEM + m) * DM + h * XHD; float a = 0.f;
#pragma unroll 2
            for (int d = 0; d < 256; d += 8) { const h8 kv = *(const h8*)(kr + d);
#pragma unroll
                for (int i = 0; i < 8; ++i) a += sq[d + i] * (float)kv[i]; }
            s[j] = a; mx = fmaxf(mx, a); }
        mx = wave_max(mx); float l = 0.f;
#pragma unroll
        for (int j = 0; j < 4; ++j) { const float p = exp2f(s[j] - mx); l += p; sp[j * 64 + lane] = p; }
        l = wave_sum(l);
#pragma unroll
        for (int j = 0; j < 4; ++j) { const int d = j * 64 + lane; const u16* vr = VMEMT + ((size_t)b * DM + h * XHD + d) * NMEM; float o = 0.f;
#pragma unroll 2
            for (int m = 0; m < 256; m += 8) { const h8 vv = *(const h8*)(vr + m);
#pragma unroll
                for (int i = 0; i < 8; ++i) o += sp[m + i] * (float)vv[i]; }
            XAO[row * DM + h * XHD + d] = f2h(o / l); }
    }
}

namespace pg8 {
#define PG8_LAS __attribute__((address_space(3)))
constexpr int BM = 256, BK = 64, HALF = 128, HTB = HALF * BK * 2, STAGE_BYTES = 8 * HTB, NXCD = 8, WGM = 8;
__host__ __device__ __forceinline__ int lds_byte(int r, int c) { const int st = (r >> 4) * 2 + (c >> 5), rr = r & 15, cc = c & 31, ob = rr * 64 + cc * 2; return st * 1024 + (ob ^ (((ob >> 9) & 1) << 5)); }
__host__ __device__ __forceinline__ void stage_rc(int b, int& R, int& C) { const int st = b / 1024, sb = b % 1024, swz = sb ^ (((sb >> 9) & 1) << 5); R = (st >> 1) * 16 + swz / 64; C = (st & 1) * 32 + (swz % 64) / 2; }
__host__ __device__ __forceinline__ int perm32(int rho) { const int n = rho >> 4, i = rho & 15; return 8 * (i >> 2) + 4 * n + (i & 3); }

struct Unit { int pm, pn; const char* a; const char* b; };
struct Gemm { int K, lda, ldb; };

struct GridOrder {
    int nM, nN, nwg, G, c;
    __device__ void init(int nM_, int nN_, int G_, int c_) { nM = nM_; nN = nN_; nwg = nM * nN; G = G_; c = c_; }
    __device__ bool tile(int i, int& pm, int& pn) const {
        const long L = (long)i * G + c; if (L >= nwg) return false;
        int wgid = (int)L; { const int q = nwg / NXCD, r = nwg % NXCD, xcd = wgid % NXCD, off = wgid / NXCD; wgid = (xcd < r ? xcd * (q + 1) : r * (q + 1) + (xcd - r) * q) + off; }
        const int nig = WGM * nN, gid = wgid / nig, fm = gid * WGM, gsz = (nM - fm) < WGM ? (nM - fm) : WGM;
        pm = fm + ((wgid % nig) % gsz); pn = (wgid % nig) / gsz; return true;
    }
};
struct DenseOrder : GridOrder {
    const u16* A; const u16* Bt; int lda, ldb;
    __device__ bool next(int i, Unit& u) const { if (!tile(i, u.pm, u.pn)) return false; u.a = (const char*)(A + (size_t)u.pm * BM * lda); u.b = (const char*)(Bt + (size_t)u.pn * BM * ldb); return true; }
};

struct EpiF32 {
    static constexpr bool PERM = false, AFTER_DRAIN = false;
    float* C; int ldc;
    __device__ __forceinline__ void operator()(const f32x4 (&acc)[2][2][4][2], const Unit& u, int wr, int wc, int fr, int fq) const {
        const int row0 = u.pm * BM + wr * 64 + fr, col0 = u.pn * BM + wc * 32 + 4 * fq;
#pragma unroll
        for (int ai = 0; ai < 2; ++ai)
#pragma unroll
            for (int m = 0; m < 4; ++m) { float* rowp = C + (size_t)(row0 + ai * HALF + m * 16) * ldc + col0;
#pragma unroll
                for (int bj = 0; bj < 2; ++bj)
#pragma unroll
                    for (int n = 0; n < 2; ++n) *(f32x4*)(rowp + bj * HALF + n * 16) = acc[ai][bj][m][n]; }
    }
};
struct EpiF16 {
    static constexpr bool PERM = true, AFTER_DRAIN = false;
    u16* O; int ldc; float scale0; int sctiles;
    __device__ __forceinline__ void operator()(const f32x4 (&acc)[2][2][4][2], const Unit& u, int wr, int wc, int fr, int fq) const {
        const int row0 = u.pm * BM + wr * 64 + fr, col0 = u.pn * BM + wc * 32 + 8 * fq;
        const float sc = u.pn < sctiles ? scale0 : 1.f;
#pragma unroll
        for (int ai = 0; ai < 2; ++ai)
#pragma unroll
            for (int m = 0; m < 4; ++m) { u16* rowp = O + (size_t)(row0 + ai * HALF + m * 16) * ldc + col0;
#pragma unroll
                for (int bj = 0; bj < 2; ++bj) { const f32x4 v0 = acc[ai][bj][m][0] * sc, v1 = acc[ai][bj][m][1] * sc;
                    u32x4 w; w.x = pk2h(v0[0], v0[1]); w.y = pk2h(v0[2], v0[3]); w.z = pk2h(v1[0], v1[1]); w.w = pk2h(v1[2], v1[3]);
                    *(u32x4*)(rowp + bj * HALF) = w; } }
    }
};
__device__ __forceinline__ float silu_mul(float g, float u) { return g * u * __builtin_amdgcn_rcpf(1.f + __builtin_amdgcn_exp2f(-LOG2E * g)); }
struct EpiSwiGLU {
    static constexpr bool PERM = true, AFTER_DRAIN = false;
    u16* O; int ldc;
    __device__ __forceinline__ void operator()(const f32x4 (&acc)[2][2][4][2], const Unit& u, int wr, int wc, int fr, int fq) const {
        const int row0 = u.pm * BM + wr * 64 + fr, col0 = u.pn * HALF + wc * 32 + 8 * fq;
#pragma unroll
        for (int ai = 0; ai < 2; ++ai)
#pragma unroll
            for (int m = 0; m < 4; ++m) { u16* rowp = O + (size_t)(row0 + ai * HALF + m * 16) * ldc + col0;
                const f32x4 g0 = acc[ai][0][m][0], g1 = acc[ai][0][m][1], u0 = acc[ai][1][m][0], u1 = acc[ai][1][m][1];
                u32x4 w; w.x = pk2h(silu_mul(g0[0], u0[0]), silu_mul(g0[1], u0[1])); w.y = pk2h(silu_mul(g0[2], u0[2]), silu_mul(g0[3], u0[3]));
                w.z = pk2h(silu_mul(g1[0], u1[0]), silu_mul(g1[1], u1[1])); w.w = pk2h(silu_mul(g1[2], u1[2]), silu_mul(g1[3], u1[3]));
                *(u32x4*)rowp = w; }
    }
};

struct XOrder : GridOrder {
    const u16* A; const u16* B; int lda; size_t bb, bh;
    __device__ bool next(int i, Unit& u) const { if (!tile(i, u.pm, u.pn)) return false;
        u.a = (const char*)(A + (size_t)u.pm * BM * lda + (size_t)u.pn * BM); u.b = (const char*)(B + (size_t)(u.pm >> 4) * bb + (size_t)u.pn * bh); return true; }
};
struct EpiSoftmax {
    static constexpr bool PERM = true, AFTER_DRAIN = true;
    u16* O; int ldc;
    __device__ __forceinline__ void fused(f32x4 (&acc)[2][2][4][2], const Unit& u, int wr, int wc, int fr, int fq, PG8_LAS unsigned char* lds, int wid, int lane) const {
        PG8_LAS float* P1 = (PG8_LAS float*)lds; PG8_LAS float* P2 = (PG8_LAS float*)(lds + 4096);
#pragma unroll
        for (int ai = 0; ai < 2; ++ai)
#pragma unroll
            for (int m = 0; m < 4; ++m) { float mx = -INFINITY;
#pragma unroll
                for (int bj = 0; bj < 2; ++bj)
#pragma unroll
                    for (int n = 0; n < 2; ++n) { const f32x4 x = acc[ai][bj][m][n]; mx = fmaxf(mx, fmaxf(fmaxf(x[0], x[1]), fmaxf(x[2], x[3]))); }
                mx = fmaxf(mx, __shfl_xor(mx, 16)); mx = fmaxf(mx, __shfl_xor(mx, 32));
                if (fq == 0) P1[(ai * HALF + wr * 64 + m * 16 + fr) * 4 + wc] = mx; }
        asm volatile("s_waitcnt lgkmcnt(0)" ::: "memory"); __builtin_amdgcn_s_barrier(); asm volatile("" ::: "memory");
#pragma unroll
        for (int ai = 0; ai < 2; ++ai)
#pragma unroll
            for (int m = 0; m < 4; ++m) { const int row = ai * HALF + wr * 64 + m * 16 + fr; const f32x4 q = *(const PG8_LAS f32x4*)(P1 + row * 4);
                const float rm = fmaxf(fmaxf(q[0], q[1]), fmaxf(q[2], q[3])); float sm = 0.f;
#pragma unroll
                for (int bj = 0; bj < 2; ++bj)
#pragma unroll
                    for (int n = 0; n < 2; ++n) { f32x4 x = acc[ai][bj][m][n];
                        x[0] = __builtin_amdgcn_exp2f(x[0] - rm); x[1] = __builtin_amdgcn_exp2f(x[1] - rm); x[2] = __builtin_amdgcn_exp2f(x[2] - rm); x[3] = __builtin_amdgcn_exp2f(x[3] - rm);
                        sm += (x[0] + x[1]) + (x[2] + x[3]); acc[ai][bj][m][n] = x; }
                sm += __shfl_xor(sm, 16); sm += __shfl_xor(sm, 32);
                if (fq == 0) P2[row * 4 + wc] = sm; }
        asm volatile("s_waitcnt lgkmcnt(0)" ::: "memory"); __builtin_amdgcn_s_barrier(); asm volatile("" ::: "memory");
        const int row0 = u.pm * BM + wr * 64 + fr, col0 = u.pn * BM + wc * 32 + 8 * fq;
#pragma unroll
        for (int ai = 0; ai < 2; ++ai)
#pragma unroll
            for (int m = 0; m < 4; ++m) { const int row = ai * HALF + wr * 64 + m * 16 + fr; const f32x4 q = *(const PG8_LAS f32x4*)(P2 + row * 4);
                const float inv = 1.0f / ((q[0] + q[1]) + (q[2] + q[3]));
                u16* rowp = O + (size_t)(row0 + ai * HALF + m * 16) * ldc + col0;
#pragma unroll
                for (int bj = 0; bj < 2; ++bj) { const f32x4 v0 = acc[ai][bj][m][0] * inv, v1 = acc[ai][bj][m][1] * inv;
                    u32x4 w; w.x = pk2h(v0[0], v0[1]); w.y = pk2h(v0[2], v0[3]); w.z = pk2h(v1[0], v1[1]); w.w = pk2h(v1[2], v1[3]);
                    *(u32x4*)(rowp + bj * HALF) = w; } }
        asm volatile("s_waitcnt lgkmcnt(0)" ::: "memory"); __builtin_amdgcn_s_barrier(); asm volatile("" ::: "memory");
    }
};

template <class Epi, class Sched, bool ALIGN_EPI = false, bool SP2 = false>
__device__ __forceinline__ void gemm_phase(PG8_LAS unsigned char* lds, const Gemm g, const Sched& S, const Epi& E, const int wid) {
    const int lane = fresh_lane(), tid = wid * 64 + lane, wr = wid >> 2, wc = wid & 3, fr = lane & 15, fq = lane >> 4;
    const int K = g.K, nt = K / BK;
    unsigned voffA[2], voffB[2];
#pragma unroll
    for (int i = 0; i < 2; ++i) { int R, C; stage_rc(tid * 16 + i * 8192, R, C); const int Rb = Epi::PERM ? ((R & ~31) + perm32(R & 31)) : R;
        voffA[i] = (unsigned)(R * g.lda + C) * 2u; voffB[i] = (unsigned)(Rb * g.ldb + C) * 2u; }
    const size_t kstep = (size_t)(BK * 2);
    const size_t hstepA = (size_t)HALF * g.lda * 2, hstepB = (size_t)HALF * g.ldb * 2;
    const unsigned ldsw = (unsigned)wid * 1024u;
    const int aoff = lds_byte(wr * 64 + fr, fq * 8), boff = lds_byte(wc * 32 + fr, fq * 8);
#define PG8_SA(b, h) (((b) * 2 + (h)) * HTB)
#define PG8_SB(b, h) ((4 + (b) * 2 + (h)) * HTB)
#define PG8_STAGE(bufoff, gbase, voff) do { _Pragma("unroll") for (int _i = 0; _i < 2; ++_i) \
        __builtin_amdgcn_global_load_lds((const unsigned*)((const char*)(gbase) + (voff)[_i]), (PG8_LAS unsigned*)(lds + (bufoff) + ldsw + _i * 8192), 16, 0, 0); } while (0)
#define PG8_LDA(dst, b, h) do { _Pragma("unroll") for (int m = 0; m < 4; ++m) _Pragma("unroll") for (int k = 0; k < 2; ++k) dst[m][k] = *(const PG8_LAS h8*)(lds + PG8_SA(b, h) + aoff + m * 2048 + k * 1024); } while (0)
#define PG8_LDB(dst, b, h) do { _Pragma("unroll") for (int n = 0; n < 2; ++n) _Pragma("unroll") for (int k = 0; k < 2; ++k) dst[n][k] = *(const PG8_LAS h8*)(lds + PG8_SB(b, h) + boff + n * 2048 + k * 1024); } while (0)
#define PG8_MMA(ai, bj, At, Bt) do { __builtin_amdgcn_s_setprio(1); _Pragma("unroll") for (int m = 0; m < 4; ++m) _Pragma("unroll") for (int n = 0; n < 2; ++n) _Pragma("unroll") for (int k = 0; k < 2; ++k) \
        acc[ai][bj][m][n] = __builtin_amdgcn_mfma_f32_16x16x32_f16(Bt[n][k], At[m][k], acc[ai][bj][m][n], 0, 0, 0); __builtin_amdgcn_s_setprio(0); } while (0)
#define PG8_WAIT_V(n) asm volatile("s_waitcnt vmcnt(" #n ")" ::: "memory")
#define PG8_WAIT_L(n) asm volatile("s_waitcnt lgkmcnt(" #n ")" ::: "memory")
#define PG8_BAR __builtin_amdgcn_s_barrier()
#define PG8_SCHED __builtin_amdgcn_sched_barrier(0)
    Unit cur, nxt; int ui = 0;
    if (!S.next(0, cur)) return;
    f32x4 acc[2][2][4][2];
#pragma unroll
    for (int a = 0; a < 2; ++a)
#pragma unroll
        for (int b = 0; b < 2; ++b)
#pragma unroll
            for (int m = 0; m < 4; ++m)
#pragma unroll
                for (int n = 0; n < 2; ++n) acc[a][b][m][n] = (f32x4){0.f, 0.f, 0.f, 0.f};
    h8 At[4][2], B0[2][2], B1[2][2];
    const char* cA = cur.a; const char* cB = cur.b;
    if constexpr (SP2) {
        PG8_STAGE(PG8_SB(0, 0), cB, voffB); PG8_STAGE(PG8_SB(0, 1), cB + hstepB, voffB); PG8_STAGE(PG8_SA(0, 0), cA, voffA); PG8_STAGE(PG8_SA(0, 1), cA + hstepA, voffA);
        if (wr == 1) PG8_BAR;
        PG8_WAIT_V(2); PG8_BAR;
        PG8_STAGE(PG8_SB(1, 0), cB + kstep, voffB); PG8_STAGE(PG8_SA(1, 0), cA + kstep, voffA); PG8_STAGE(PG8_SB(1, 1), cB + hstepB + kstep, voffB);
        PG8_WAIT_V(6); PG8_BAR;
    } else {
        PG8_STAGE(PG8_SB(0, 0), cB, voffB); PG8_STAGE(PG8_SA(0, 0), cA, voffA); PG8_STAGE(PG8_SB(0, 1), cB + hstepB, voffB); PG8_STAGE(PG8_SA(0, 1), cA + hstepA, voffA);
        if (wr == 1) PG8_BAR;
        PG8_WAIT_V(4); PG8_BAR;
        PG8_STAGE(PG8_SB(1, 0), cB + kstep, voffB); PG8_STAGE(PG8_SA(1, 0), cA + kstep, voffA); PG8_STAGE(PG8_SB(1, 1), cB + hstepB + kstep, voffB);
        PG8_WAIT_V(6); PG8_BAR;
    }
    for (;;) {
        const bool has_next = S.next(ui + 1, nxt);
        const char* nA = has_next ? nxt.a : cA; const char* nB = has_next ? nxt.b : cB;
        for (int t = 0; t < nt; t += 2) {
            const bool last = (t == nt - 2);
            const char* a1 = cA + (size_t)(t + 1) * kstep;
            const char* a2 = last ? nA : cA + (size_t)(t + 2) * kstep; const char* b2 = last ? nB : cB + (size_t)(t + 2) * kstep;
            const char* a3 = a2 + kstep; const char* b3 = b2 + kstep;
            if constexpr (SP2) {
            PG8_LDB(B0, 0, 0); PG8_LDB(B1, 0, 1); PG8_SCHED; PG8_LDA(At, 0, 0); PG8_STAGE(PG8_SA(1, 1), a1 + hstepA, voffA);
            PG8_WAIT_V(8); PG8_WAIT_L(0); PG8_BAR; PG8_MMA(0, 0, At, B0); PG8_MMA(0, 1, At, B1); PG8_BAR; PG8_SCHED;
            PG8_LDA(At, 0, 1); PG8_STAGE(PG8_SB(0, 0), b2, voffB); PG8_STAGE(PG8_SB(0, 1), b2 + hstepB, voffB); PG8_STAGE(PG8_SA(0, 0), a2, voffA);
            PG8_WAIT_V(8); PG8_WAIT_L(0); PG8_BAR; PG8_MMA(1, 0, At, B0); PG8_MMA(1, 1, At, B1); PG8_BAR; PG8_SCHED;
            PG8_LDB(B0, 1, 0); PG8_LDB(B1, 1, 1); PG8_SCHED; PG8_LDA(At, 1, 0); PG8_STAGE(PG8_SA(0, 1), a2 + hstepA, voffA);
            PG8_WAIT_V(8); PG8_WAIT_L(0); PG8_BAR; PG8_MMA(0, 0, At, B0); PG8_MMA(0, 1, At, B1); PG8_BAR; PG8_SCHED;
            PG8_LDA(At, 1, 1); PG8_STAGE(PG8_SB(1, 0), b3, voffB); PG8_STAGE(PG8_SB(1, 1), b3 + hstepB, voffB); PG8_STAGE(PG8_SA(1, 0), a3, voffA);
            PG8_WAIT_V(8); PG8_WAIT_L(0); PG8_BAR; PG8_MMA(1, 0, At, B0); PG8_MMA(1, 1, At, B1); PG8_BAR; PG8_SCHED;
            } else {
            PG8_LDB(B0, 0, 0); PG8_SCHED; PG8_LDA(At, 0, 0); PG8_STAGE(PG8_SA(1, 1), a1 + hstepA, voffA);
            PG8_WAIT_L(8); PG8_BAR; PG8_WAIT_L(0); PG8_MMA(0, 0, At, B0); PG8_BAR; PG8_SCHED;
            PG8_LDB(B1, 0, 1); PG8_STAGE(PG8_SB(0, 0), b2, voffB);
            PG8_BAR; PG8_WAIT_L(0); PG8_MMA(0, 1, At, B1); PG8_BAR;
            PG8_LDA(At, 0, 1); PG8_STAGE(PG8_SA(0, 0), a2, voffA);
            PG8_BAR; PG8_WAIT_L(0); PG8_MMA(1, 0, At, B0); PG8_BAR; PG8_SCHED;
            PG8_STAGE(PG8_SB(0, 1), b2 + hstepB, voffB);
            PG8_WAIT_V(6); PG8_BAR; PG8_MMA(1, 1, At, B1); PG8_BAR;
            PG8_LDB(B0, 1, 0); PG8_SCHED; PG8_LDA(At, 1, 0); PG8_STAGE(PG8_SA(0, 1), a2 + hstepA, voffA);
            PG8_WAIT_L(8); PG8_BAR; PG8_WAIT_L(0); PG8_MMA(0, 0, At, B0); PG8_BAR; PG8_SCHED;
            PG8_LDB(B1, 1, 1); PG8_STAGE(PG8_SB(1, 0), b3, voffB);
            PG8_BAR; PG8_WAIT_L(0); PG8_MMA(0, 1, At, B1); PG8_BAR;
            PG8_LDA(At, 1, 1); PG8_STAGE(PG8_SA(1, 0), a3, voffA);
            PG8_BAR; PG8_WAIT_L(0); PG8_MMA(1, 0, At, B0); PG8_BAR; PG8_SCHED;
            PG8_STAGE(PG8_SB(1, 1), b3 + hstepB, voffB);
            PG8_WAIT_V(6); PG8_BAR; PG8_MMA(1, 1, At, B1); PG8_BAR;
            }
        }
        if constexpr (ALIGN_EPI) { if (wr == 0) PG8_BAR; }
        if constexpr (!Epi::AFTER_DRAIN) { E(acc, cur, wr, wc, fr, fq); }
        if (!has_next) break;
#pragma unroll
        for (int a = 0; a < 2; ++a)
#pragma unroll
            for (int b = 0; b < 2; ++b)
#pragma unroll
                for (int m = 0; m < 4; ++m)
#pragma unroll
                    for (int n = 0; n < 2; ++n) acc[a][b][m][n] = (f32x4){0.f, 0.f, 0.f, 0.f};
        cur = nxt; cA = nA; cB = nB; ++ui;
        if constexpr (ALIGN_EPI) { if (wr == 1) PG8_BAR; }
    }
    PG8_WAIT_V(0);
    if constexpr (!ALIGN_EPI) { if (wr == 0) PG8_BAR; }
    PG8_BAR;
    if constexpr (Epi::AFTER_DRAIN) { E.fused(acc, cur, wr, wc, fr, fq, lds, wid, lane); }
#undef PG8_SA
#undef PG8_SB
#undef PG8_STAGE
#undef PG8_LDA
#undef PG8_LDB
#undef PG8_MMA
#undef PG8_WAIT_V
#undef PG8_WAIT_L
#undef PG8_BAR
#undef PG8_SCHED
}
}

namespace moba {
typedef short s16x4 __attribute__((ext_vector_type(4)));
typedef short s16x8 __attribute__((ext_vector_type(8)));
constexpr int D = 64, PIN = DIN, POUT = DM;
constexpr int NW = 8, QBLK = 32, QB = QBLK * NW, KVBLK = 64;
__device__ __forceinline__ int crow(int r, int hi) { return (r & 3) + 8 * (r >> 2) + 4 * hi; }
#define SBAR() __builtin_amdgcn_sched_barrier(0)
__device__ __forceinline__ void cmask(f32x16& p0, f32x16& p1, int jb, int qrel, int hi) {
    const float NEG = -INFINITY; int kb = 64 * jb + 4 * hi;
#pragma unroll
    for (int r = 0; r < 16; ++r) { int kv = kb + (r & 3) + 8 * (r >> 2); if (kv > qrel) p0[r] = NEG; if (kv + 32 > qrel) p1[r] = NEG; }
}
constexpr int NSLOT = 3, SLOTB = 8192;
constexpr int LDS_K = 0, LDS_V = NSLOT * SLOTB, LDS_WS = 2 * NSLOT * SLOTB, LDS_OST = LDS_WS + NW * 64 * 4, LDS_BYTES = LDS_OST + NW * 4096;
constexpr float BIG = 60000.f;
__device__ __forceinline__ void glds16(const void* gsrc, unsigned lds_dst) { unsigned keep;
    asm volatile("s_mov_b32 %0, m0\n\ts_mov_b32 m0, %2\n\ts_nop 0\n\tglobal_load_lds_dwordx4 %1, off\n\ts_mov_b32 m0, %0" : "=&s"(keep) : "v"(gsrc), "s"(lds_dst) : "memory"); }
__device__ __forceinline__ float max3f(float a, float b, float c) { float r; asm("v_max3_f32 %0, %1, %2, %3" : "=v"(r) : "v"(a), "v"(b), "v"(c)); return r; }
__device__ __forceinline__ float max2f(float a, float b) { float r; asm("v_max_f32_e32 %0, %1, %2" : "=v"(r) : "v"(a), "v"(b)); return r; }
__device__ __forceinline__ float fadd_s(float a, float b) { float r; asm("v_add_f32_e32 %0, %1, %2" : "=v"(r) : "v"(a), "v"(b)); return r; }
__device__ __forceinline__ float fsub_s(float a, float b) { float r; asm("v_sub_f32_e32 %0, %1, %2" : "=v"(r) : "v"(a), "v"(b)); return r; }
#define WAIT_BAR(N) asm volatile("s_waitcnt vmcnt(" #N ") lgkmcnt(0)\n\ts_barrier" ::: "memory")
#define MFMA32(a, b, c) __builtin_amdgcn_mfma_f32_32x32x16_f16(a, b, c, 0, 0, 0)
__device__ __forceinline__ void qkt(f32x16& p0, f32x16& p1, const char* Kslot, const h8* qr, const f32x16& c0, const f32x16& c1, int r32, int hi) {
    const char* kb = Kslot + hi * 1024 + r32 * 16;
#pragma unroll
    for (int d0 = 0; d0 < 4; ++d0) {
        const h8 b0 = *reinterpret_cast<const h8*>(kb + d0 * 2048);
        const h8 b1 = *reinterpret_cast<const h8*>(kb + d0 * 2048 + 512);
        if (d0 == 0) { p0 = MFMA32(b0, qr[0], c0); p1 = MFMA32(b1, qr[0], c1); }
        else { p0 = MFMA32(b0, qr[d0], p0); p1 = MFMA32(b1, qr[d0], p1); } }
}
typedef __attribute__((address_space(3))) const char* lds_cptr;
typedef short v4i16_t __attribute__((ext_vector_type(4)));
#define LDSH8(p) (*(const __attribute__((address_space(3))) h8*)(p))
__device__ __forceinline__ void kload8(h8* kf, lds_cptr kp) {
    kf[0] = LDSH8(kp); kf[1] = LDSH8(kp + 512); kf[2] = LDSH8(kp + 2048); kf[3] = LDSH8(kp + 2560);
    kf[4] = LDSH8(kp + 4096); kf[5] = LDSH8(kp + 4608); kf[6] = LDSH8(kp + 6144); kf[7] = LDSH8(kp + 6656);
}
__device__ __forceinline__ void kload2(h8* kf, lds_cptr kp, int j) { kf[2 * j] = LDSH8(kp + j * 2048); kf[2 * j + 1] = LDSH8(kp + j * 2048 + 512); }
__device__ __forceinline__ s16x4 vtr(lds_cptr p) { return __builtin_bit_cast(s16x4, __builtin_amdgcn_ds_read_tr16_b64_v4i16((__attribute__((address_space(3))) v4i16_t*)p)); }
__device__ __forceinline__ h8 mk8(s16x4 lo, s16x4 hi) { s16x8 v = {lo[0], lo[1], lo[2], lo[3], hi[0], hi[1], hi[2], hi[3]}; return __builtin_bit_cast(h8, v); }
__device__ __forceinline__ float rowmax(const f32x16& p0, const f32x16& p1) {
    float a = max3f(p0[0], p0[1], p1[0]), b = max3f(p0[2], p0[3], p1[1]); a = max3f(a, p1[2], p1[3]);
#pragma unroll
    for (int r = 4; r < 16; r += 4) { a = max3f(a, p0[r], p0[r + 1]); b = max3f(b, p0[r + 2], p0[r + 3]); a = max3f(a, p1[r], p1[r + 1]); b = max3f(b, p1[r + 2], p1[r + 3]); }
    const float m = max2f(a, b);
    auto rr = __builtin_amdgcn_permlane32_swap(__float_as_uint(m), __float_as_uint(m), false, false);
    return max2f(__uint_as_float(rr[0]), __uint_as_float(rr[1]));
}
__device__ __forceinline__ void pv(f32x16* o, int vb, h8 pa0, h8 pa1, h8 pa2, h8 pa3) {
#pragma unroll
    for (int d0 = 0; d0 < 2; ++d0) { s16x4 lo[4], hi[4];
#pragma unroll
        for (int ks = 0; ks < 4; ++ks) {
            asm volatile("ds_read_b64_tr_b16 %0,%1 offset:%c2" : "=&v"(lo[ks]) : "v"(vb), "i"(d0 * 4096 + ks * 1024) : "memory");
            asm volatile("ds_read_b64_tr_b16 %0,%1 offset:%c2" : "=&v"(hi[ks]) : "v"(vb), "i"(d0 * 4096 + ks * 1024 + 512) : "memory"); }
        asm volatile("s_waitcnt lgkmcnt(0)" ::: "memory"); SBAR();
        o[d0] = MFMA32(pa0, mk8(lo[0], hi[0]), o[d0]);
        o[d0] = MFMA32(pa1, mk8(lo[1], hi[1]), o[d0]);
        o[d0] = MFMA32(pa2, mk8(lo[2], hi[2]), o[d0]);
        o[d0] = MFMA32(pa3, mk8(lo[3], hi[3]), o[d0]);
    }
}

template <int THRL> __device__ __forceinline__ void attn_unit(int b, int h, int qb, const u16* PROJ, const float* KMEAN, u16* MIX, char* shm, const int wid) {
    const int lane = fresh_lane(), r32 = lane & 31, hi = lane >> 5;
    const long rowbase = (long)b * SEQ; const int q0 = qb * QB;
    const u16* Qw = PROJ + (rowbase + q0 + wid * QBLK) * PIN + h * D;
    const u16* Kh = PROJ + rowbase * PIN + 512 + h * D; const u16* Vh = PROJ + rowbase * PIN + 1024 + h * D;
    const unsigned lds0 = (unsigned)(uintptr_t)shm;
    float* wsf = (float*)(shm + LDS_WS) + wid * 64;
    const u16* ksrc = Kh + (long)lane * PIN + wid * 8;
    const u16* vsrc = Vh + (long)(16 * (wid & 3) + (lane >> 2)) * PIN + (wid >> 2) * 32 + (lane & 3) * 8;
    const unsigned kdst = lds0 + LDS_K + wid * 1024, vdst = lds0 + LDS_V + wid * 1024;
#define KT(t) (((t) < 4) ? (4 * qb + (t)) : ((t) - 4))
#define DMA_K(t, slot) glds16(ksrc + (long)KT(t) * KVBLK * PIN, (unsigned)__builtin_amdgcn_readfirstlane(kdst + (slot)))
#define DMA_V(t, slot) glds16(vsrc + (long)KT(t) * KVBLK * PIN, (unsigned)__builtin_amdgcn_readfirstlane(vdst + (slot)))
    const int vb0 = (int)(lds0 + LDS_V) + ((lane >> 4) & 1) * 32 + (lane & 3) * 8 + (4 * hi + ((lane & 15) >> 2)) * 64;
    const char* Kbase = shm + LDS_K; h8 kf[8];
    const lds_cptr shm3 = (lds_cptr)shm; const lds_cptr kp0 = shm3 + LDS_K + hi * 1024 + r32 * 16; const lds_cptr vp0 = shm3 + LDS_V + ((lane >> 4) & 1) * 32 + (lane & 3) * 8 + (4 * hi + ((lane & 15) >> 2)) * 64;
    const int NT = 4 * (qb + 1);
    DMA_K(0, 0); DMA_V(0, 0); DMA_K(1, SLOTB);
    h8 qr[4];
#pragma unroll
    for (int d0 = 0; d0 < 4; ++d0) qr[d0] = *reinterpret_cast<const h8*>(&Qw[(long)r32 * PIN + d0 * 16 + hi * 8]);
    unsigned selmask = 0u;
    {
        const float* kmb = KMEAN + (size_t)b * NBLK * 512 + h * D + 8 * hi;
        float v1 = -INFINITY, v2 = -INFINITY, v3 = -INFINITY; int i1 = -1, i2 = -1, i3 = -1;
        for (int n = 0; n < qb; ++n) { const float* kp = kmb + n * 512; float a = 0.f;
#pragma unroll
            for (int d0 = 0; d0 < 4; ++d0) { const f32x4 x0 = *(const f32x4*)(kp + 16 * d0), x1 = *(const f32x4*)(kp + 16 * d0 + 4);
                a += (float)qr[d0][0] * x0[0] + (float)qr[d0][1] * x0[1] + (float)qr[d0][2] * x0[2] + (float)qr[d0][3] * x0[3]
                   + (float)qr[d0][4] * x1[0] + (float)qr[d0][5] * x1[1] + (float)qr[d0][6] * x1[2] + (float)qr[d0][7] * x1[3]; }
            a += __shfl_xor(a, 32);
            if (a > v1) { v3 = v2; i3 = i2; v2 = v1; i2 = i1; v1 = a; i1 = n; }
            else if (a > v2) { v3 = v2; i3 = i2; v2 = a; i2 = n; }
            else if (a > v3) { v3 = a; i3 = n; } }
        if (i1 >= 0) selmask |= 1u << i1; if (i2 >= 0) selmask |= 1u << i2; if (i3 >= 0) selmask |= 1u << i3;
    }
#define SGPRF(x) __builtin_bit_cast(float, __builtin_amdgcn_readfirstlane(__builtin_bit_cast(int, (float)(x))))
    const float slope2 = SGPRF(__builtin_amdgcn_exp2f(-(float)(h + 1)) * LOG2E), c32 = SGPRF(32.f * slope2);
    const float s1_ = slope2, s2_ = SGPRF(2.f * slope2), s3_ = SGPRF(3.f * slope2), s8_ = SGPRF(8.f * slope2), s16_ = SGPRF(16.f * slope2), s24_ = SGPRF(24.f * slope2);
    const float hi4 = hi ? 4.f * slope2 : 0.f;
    const int qrel = wid * QBLK + r32, qpos = q0 + qrel;
    float mhat = 0.f, l_reg = 0.f; f32x16 o[2]; o[0] = f32x16{}; o[1] = f32x16{};
#define CMASK(P0, P1, t) do { if ((t) < 4) cmask(P0, P1, (t), qrel, hi); } while (0)
#define CINIT(C0, C1, t) do { const bool sel_ = ((t) < 4) || (((selmask >> (((t) - 4) >> 2)) & 1u) != 0u); \
        const float base_ = (sel_ ? (slope2 * (float)(64 * KT(t) - qpos) - mhat) : -BIG) + hi4; \
        const float g0_ = base_, g1_ = base_ + s8_, g2_ = base_ + s16_, g3_ = base_ + s24_; \
        C0[0] = g0_; C0[1] = g0_ + s1_; C0[2] = g0_ + s2_; C0[3] = g0_ + s3_; C0[4] = g1_; C0[5] = g1_ + s1_; C0[6] = g1_ + s2_; C0[7] = g1_ + s3_; \
        C0[8] = g2_; C0[9] = g2_ + s1_; C0[10] = g2_ + s2_; C0[11] = g2_ + s3_; C0[12] = g3_; C0[13] = g3_ + s1_; C0[14] = g3_ + s2_; C0[15] = g3_ + s3_; \
        _Pragma("unroll") for (int r = 0; r < 16; ++r) { C1[r] = C0[r] + c32; } } while (0)
    bool resc = false;
#define START(P0, P1) do { const float rm = rowmax(P0, P1); resc = false; \
    { const float dl = rm; mhat = fadd_s(mhat, dl); \
      _Pragma("unroll") for (int r = 0; r < 16; ++r) { P0[r] = fsub_s(P0[r], dl); P1[r] = fsub_s(P1[r], dl); } } \
    _Pragma("unroll") for (int r = 0; r < 16; ++r) P0[r] = __builtin_amdgcn_exp2f(P0[r]); } while (0)
#define RESC() do { if (resc) { asm volatile("s_waitcnt lgkmcnt(0)" ::: "memory"); \
      _Pragma("unroll") for (int d_ = 0; d_ < 2; ++d_) _Pragma("unroll") for (int r = 0; r < 16; ++r) o[d_][r] *= wsf[crow(r, hi)]; } } while (0)
    f32x16 pA0, pA1, pB0, pB1;
    int sl_prev = 0, sl_cur = 0, sl_next = SLOTB;
#define ROT() do { sl_prev = sl_cur; sl_cur = sl_next; sl_next = (sl_next == (NSLOT - 1) * SLOTB) ? 0 : sl_next + SLOTB; } while (0)
    DMA_K(2, 2 * SLOTB);
    WAIT_BAR(3);
    CINIT(pB0, pB1, 0);
    qkt(pA0, pA1, Kbase, qr, pB0, pB1, r32, hi); asm volatile("s_nop 15\n\ts_nop 7" : "+v"(pA0), "+v"(pA1)); CMASK(pA0, pA1, 0);
    START(pA0, pA1);
    _Pragma("unroll") for (int r = 0; r < 16; ++r) pA1[r] = __builtin_amdgcn_exp2f(pA1[r]);
    WAIT_BAR(0);
    DMA_K(3, 0); DMA_V(1, SLOTB);
    ROT();
    kload8(kf, kp0 + sl_cur);
    WAIT_BAR(2);
    s16x4 vlo[8], vhi[8]; u32x4 pw0, pw1, pw2, pw3;
#define PKW(P, B) pk2h(P[B], P[B + 1])
#define PAF(k) __builtin_bit_cast(h8, pw##k)
#define VFR(i) mk8(vlo[i], vhi[i])
#define PINV(x) asm volatile("" : "+v"(x))
#define MX3(a, b, c) __builtin_fmaxf(__builtin_fmaxf((a), (b)), (c))
#define GAPA(MF, A0, A1, A2, A3, W0, W1, PW) do { MF; sacc += A0; sacc += A1; sacc += A2; sacc += A3; PINV(sacc); W0; W1; PINV(PW); SBAR(); } while (0)
#define EX(v) __builtin_amdgcn_exp2f(v)
#define GAPB(MF, X, B) do { MF; X[B] = EX(X[B]); X[B + 1] = EX(X[B + 1]); X[B + 2] = EX(X[B + 2]); X[B + 3] = EX(X[B + 3]); PINV(X); SBAR(); } while (0)
#define VRD(i) do { vlo[i] = vtr(vp_ + (((i) >> 2) * 4096 + ((i) & 3) * 1024)); vhi[i] = vtr(vp_ + (((i) >> 2) * 4096 + ((i) & 3) * 1024 + 512)); } while (0)
#define KRD(G, j) do { if (G) { kload2(kf, kp0 + sl_next, j); SBAR(); } } while (0)
#define STEP(C0, C1, P0, P1, t, GK, GV, GL) do { SBAR(); \
    CINIT(C0, C1, t); PINV(C0); PINV(C1); SBAR(); \
    const lds_cptr vp_ = vp0 + sl_prev; \
    VRD(0); SBAR(); float sacc = (P0[0] + P0[1]); \
    GAPA(C0 = MFMA32(kf[0], qr[0], C0), P0[2], P0[3], P0[4], P0[5],     pw0[0] = PKW(P0, 0), pw0[1] = PKW(P0, 2), pw0); \
    VRD(4); SBAR(); GAPA(C1 = MFMA32(kf[1], qr[0], C1), P0[6], P0[7], P0[8], P0[9],     pw0[2] = PKW(P0, 4), pw0[3] = PKW(P0, 6), pw0); \
    VRD(1); SBAR(); GAPA(C0 = MFMA32(kf[2], qr[1], C0),   P0[10], P0[11], P0[12], P0[13], pw1[0] = PKW(P0, 8), pw1[1] = PKW(P0, 10), pw1); \
    VRD(5); SBAR(); GAPA(C1 = MFMA32(kf[3], qr[1], C1),   P0[14], P0[15], P1[0], P1[1],   pw1[2] = PKW(P0, 12), pw1[3] = PKW(P0, 14), pw1); \
    VRD(2); SBAR(); GAPA(C0 = MFMA32(kf[4], qr[2], C0),   P1[2], P1[3], P1[4], P1[5],     pw2[0] = PKW(P1, 0), pw2[1] = PKW(P1, 2), pw2); \
    VRD(6); SBAR(); GAPA(C1 = MFMA32(kf[5], qr[2], C1),   P1[6], P1[7], P1[8], P1[9],     pw2[2] = PKW(P1, 4), pw2[3] = PKW(P1, 6), pw2); \
    VRD(3); SBAR(); GAPA(C0 = MFMA32(kf[6], qr[3], C0),   P1[10], P1[11], P1[12], P1[13], pw3[0] = PKW(P1, 8), pw3[1] = PKW(P1, 10), pw3); \
    VRD(7); SBAR(); GAPA(C1 = MFMA32(kf[7], qr[3], C1),   P1[14], P1[15], 0.f, 0.f,       pw3[2] = PKW(P1, 12), pw3[3] = PKW(P1, 14), pw3); \
    l_reg += sacc; \
    if (GK) { DMA_K((t) + 3, sl_cur); } if (GV) { DMA_V((t) + 1, sl_next); } \
    CMASK(C0, C1, t); \
    { float a = MX3(C0[0], C0[1], C1[0]), b_ = MX3(C0[2], C0[3], C1[1]); a = MX3(a, C1[2], C1[3]); \
      _Pragma("unroll") for (int r = 4; r < 16; r += 4) { a = MX3(a, C0[r], C0[r + 1]); b_ = MX3(b_, C0[r + 2], C0[r + 3]); a = MX3(a, C1[r], C1[r + 1]); b_ = MX3(b_, C1[r + 2], C1[r + 3]); } \
      float rm = __builtin_fmaxf(a, b_); { auto rr = __builtin_amdgcn_permlane32_swap(__float_as_uint(rm), __float_as_uint(rm), false, false); rm = __builtin_fmaxf(__uint_as_float(rr[0]), __uint_as_float(rr[1])); } \
      resc = false; \
      if (__builtin_expect(__any(rm > (float)THRL), 0)) { const float dl = __builtin_fmaxf(rm, 0.f); mhat += dl; \
        _Pragma("unroll") for (int r = 0; r < 16; ++r) { C0[r] -= dl; C1[r] -= dl; } \
        const float f = __builtin_amdgcn_exp2f(-dl); l_reg *= f; if (hi == 0) wsf[r32] = f; resc = true; } } \
    SBAR(); \
    GAPB(o[0] = MFMA32(PAF(0), VFR(0), o[0]), C0, 0); \
    GAPB(o[1] = MFMA32(PAF(0), VFR(4), o[1]), C0, 4); \
    KRD(GL, 0); GAPB(o[0] = MFMA32(PAF(1), VFR(1), o[0]), C0, 8); \
    KRD(GL, 1); GAPB(o[1] = MFMA32(PAF(1), VFR(5), o[1]), C0, 12); \
    KRD(GL, 2); GAPB(o[0] = MFMA32(PAF(2), VFR(2), o[0]), C1, 0); \
    KRD(GL, 3); GAPB(o[1] = MFMA32(PAF(2), VFR(6), o[1]), C1, 4); \
    GAPB(o[0] = MFMA32(PAF(3), VFR(3), o[0]), C1, 8); \
    GAPB(o[1] = MFMA32(PAF(3), VFR(7), o[1]), C1, 12); \
    } while (0)
#define ENDW(tt) do { if ((tt) + 3 < NT) { WAIT_BAR(2); } else if ((tt) + 2 < NT) { WAIT_BAR(1); } else { WAIT_BAR(0); } } while (0)
    int t = 1;
    for (; t + 1 < NT; t += 2) {
        STEP(pB0, pB1, pA0, pA1, t, (t + 3 < NT), (t + 1 < NT), (t + 1 < NT));       ENDW(t);     RESC(); ROT();
        STEP(pA0, pA1, pB0, pB1, t + 1, (t + 4 < NT), (t + 2 < NT), (t + 2 < NT));   ENDW(t + 1); RESC(); ROT();
    }
    STEP(pB0, pB1, pA0, pA1, NT - 1, false, false, false); RESC();
    { float sacc = pB0[0] + pB0[1]; _Pragma("unroll") for (int r = 2; r < 16; ++r) sacc += pB0[r]; _Pragma("unroll") for (int r = 0; r < 16; ++r) sacc += pB1[r]; l_reg += sacc;
      pw0 = (u32x4){PKW(pB0, 0), PKW(pB0, 2), PKW(pB0, 4), PKW(pB0, 6)}; pw1 = (u32x4){PKW(pB0, 8), PKW(pB0, 10), PKW(pB0, 12), PKW(pB0, 14)};
      pw2 = (u32x4){PKW(pB1, 0), PKW(pB1, 2), PKW(pB1, 4), PKW(pB1, 6)}; pw3 = (u32x4){PKW(pB1, 8), PKW(pB1, 10), PKW(pB1, 12), PKW(pB1, 14)};
      SBAR(); pv(o, vb0 + sl_cur, PAF(0), PAF(1), PAF(2), PAF(3)); }
    { auto rr = __builtin_amdgcn_permlane32_swap(__float_as_uint(l_reg), __float_as_uint(l_reg), false, false); l_reg = __uint_as_float(rr[0]) + __uint_as_float(rr[1]); }
    if (hi == 0) wsf[32 + r32] = l_reg; asm volatile("s_waitcnt lgkmcnt(0)" ::: "memory");
    float rli[16];
#pragma unroll
    for (int r = 0; r < 16; ++r) rli[r] = __builtin_amdgcn_rcpf(wsf[32 + crow(r, hi)]);
    u16* Ow = MIX + (rowbase + q0 + wid * QBLK) * POUT + h * D;
    { u16* stg = (u16*)(shm + LDS_OST) + wid * 2048;
#pragma unroll
      for (int r = 0; r < 16; ++r) { const int orow = crow(r, hi);
#pragma unroll
        for (int d0 = 0; d0 < 2; ++d0) stg[orow * 64 + d0 * 32 + r32] = f2h(o[d0][r] * rli[r]); }
      asm volatile("s_waitcnt lgkmcnt(0)" ::: "memory");
#pragma unroll
      for (int i = 0; i < 4; ++i) { const int row = i * 8 + (lane >> 3), ch = lane & 7; const u32x4 v = *(const u32x4*)(stg + row * 64 + ch * 8); *(u32x4*)(Ow + (long)row * POUT + ch * 8) = v; } }
    asm volatile("s_waitcnt lgkmcnt(0)\n\ts_barrier" ::: "memory");
#undef SGPRF
#undef KT
#undef DMA_K
#undef DMA_V
#undef CMASK
#undef CINIT
#undef START
#undef RESC
#undef ROT
#undef PKW
#undef PAF
#undef VFR
#undef PINV
#undef MX3
#undef GAPA
#undef GAPB
#undef EX
#undef VRD
#undef KRD
#undef STEP
#undef ENDW
}
#undef SBAR
#undef WAIT_BAR
#undef MFMA32
#undef LDSH8
}

namespace poolu {
constexpr int RS = 272;
constexpr int LDS_D = 0, LDS_W = 256 * RS, LDS_BYTES = LDS_W + 128 * RS;
__device__ __forceinline__ void pool_unit(int pm, int g, const u16* PROJ, const u16* WPT, const float* pool_scale, u16* MIX, unsigned char* shm, const int wid) {
    const int lane = fresh_lane(), tid = wid * 64 + lane;
    const int w = 2 << g;
#pragma unroll
    for (int i = 0; i < 4; ++i) { const int e = tid + 512 * i, d = e >> 4, ch = e & 15;
        *(u32x4*)(shm + LDS_W + d * RS + ch * 16) = *(const u32x4*)(WPT + (size_t)d * 512 + g * 128 + ch * 8); }
    { const int ch = tid & 15, run = tid >> 4, t0 = (pm & 15) * 256 + run * 8;
      const u16* pcol = PROJ + (size_t)(pm >> 4) * SEQ * DIN + 1536 + g * 128 + ch * 8;
      float sacc[8];
#pragma unroll
      for (int j = 0; j < 8; ++j) sacc[j] = 0.f;
      for (int p = max(0, t0 - w + 1); p < t0; ++p) { const h8 v = *(const h8*)(pcol + (size_t)p * DIN);
#pragma unroll
          for (int j = 0; j < 8; ++j) sacc[j] += (float)v[j]; }
#pragma unroll 1
      for (int i = 0; i < 8; ++i) { const int p = t0 + i; const h8 v = *(const h8*)(pcol + (size_t)p * DIN);
          const int lo = max(p + 1 - w, 0); const float inv = 1.0f / (float)(p + 1 - lo);
          u32x4 o; float dd[8];
#pragma unroll
          for (int j = 0; j < 8; ++j) { sacc[j] += (float)v[j]; dd[j] = sacc[j] * inv - (float)v[j]; }
          o.x = pk2h(dd[0], dd[1]); o.y = pk2h(dd[2], dd[3]); o.z = pk2h(dd[4], dd[5]); o.w = pk2h(dd[6], dd[7]);
          *(u32x4*)(shm + LDS_D + (run * 8 + i) * RS + ch * 16) = o;
          if (p + 1 - w >= 0) { const h8 vo = *(const h8*)(pcol + (size_t)(p + 1 - w) * DIN);
#pragma unroll
              for (int j = 0; j < 8; ++j) sacc[j] -= (float)vo[j]; } } }
    __syncthreads();
    const int fr = lane & 15, fq = lane >> 4;
    f32x4 acc[2][8];
#pragma unroll
    for (int m = 0; m < 2; ++m)
#pragma unroll
        for (int n = 0; n < 8; ++n) acc[m][n] = (f32x4){0.f, 0.f, 0.f, 0.f};
#pragma unroll
    for (int k = 0; k < 4; ++k) { h8 af[2];
#pragma unroll
        for (int m = 0; m < 2; ++m) af[m] = *(const h8*)(shm + LDS_D + (wid * 32 + m * 16 + fr) * RS + (k * 32 + fq * 8) * 2);
#pragma unroll
        for (int n = 0; n < 8; ++n) { const h8 bf = *(const h8*)(shm + LDS_W + (n * 16 + fr) * RS + (k * 32 + fq * 8) * 2);
#pragma unroll
            for (int m = 0; m < 2; ++m) acc[m][n] = __builtin_amdgcn_mfma_f32_16x16x32_f16(bf, af[m], acc[m][n], 0, 0, 0); } }
#pragma unroll
    for (int n = 0; n < 8; ++n) { const f32x4 sc = *(const f32x4*)(pool_scale + g * 128 + n * 16 + 4 * fq);
#pragma unroll
        for (int m = 0; m < 2; ++m) { const f32x4 y = acc[m][n] * sc; u32x2 o; o.x = pk2h(y[0], y[1]); o.y = pk2h(y[2], y[3]);
            *(u32x2*)(MIX + (size_t)(pm * 256 + wid * 32 + m * 16 + fr) * DM + 512 + g * 128 + n * 16 + 4 * fq) = o; } }
    __syncthreads();
}
}

namespace cg = cooperative_groups;
constexpr int NWAVES = 8, NTHREADS = NWAVES * 64;
constexpr int LDS_BYTES = 147456;
struct Args { Ptrs p; };

__global__ void __launch_bounds__(NTHREADS, 2) mega(Args args) {
    extern __shared__ __attribute__((aligned(16))) unsigned char lds[];
    cg::grid_group grid = cg::this_grid();
    const Ptrs& P = args.p;
    unsigned char* ws = P.ws;
    const int wave = __builtin_amdgcn_readfirstlane((int)threadIdx.x >> 6);
#define lane fresh_lane()
    const int G = gridDim.x, gw = blockIdx.x * NWAVES + wave, NGW = G * NWAVES;
    float* wl = (float*)(lds + wave * 16384);
    u16 *XN = (u16*)(ws + WS_XN), *ACT = (u16*)(ws + WS_ACT), *PROJ = (u16*)(ws + WS_PROJ), *MIX = (u16*)(ws + WS_MIX), *XQ = (u16*)(ws + WS_XQ), *XAO = (u16*)(ws + WS_XAO);
    u16* XP = (u16*)(ws + WS_XP);
    u16 *MEMN = (u16*)(ws + WS_MEMN), *KMEM = (u16*)(ws + WS_KMEM), *VMEMT = (u16*)(ws + WS_VMEMT);
    float *F32A = (float*)(ws + WS_F32A), *F32B = (float*)(ws + WS_F32B), *KMEAN = (float*)(ws + WS_KMEAN), *OUT = P.out;
#define GSYNC() grid.sync()
    PG8_LAS unsigned char* ldsl = (PG8_LAS unsigned char*)lds;
#define DENSE(EPI, epi, Aptr, lda_, Btptr, ldb_, nM_, nN_, K_, ALIGN) do { pg8::DenseOrder S_; S_.init(nM_, nN_, G, (int)blockIdx.x); S_.A = (Aptr); S_.Bt = (Btptr); S_.lda = (lda_); S_.ldb = (ldb_); \
        pg8::gemm_phase<EPI, pg8::DenseOrder, ALIGN, true>(ldsl, pg8::Gemm{K_, lda_, ldb_}, S_, epi, wave); } while (0)
    prologue(P, gw, NGW, lane, wl);
    GSYNC();
    { pg8::EpiSwiGLU e{ACT, DFF}; DENSE(pg8::EpiSwiGLU, e, XN, DM, (u16*)(ws + WS_W1A), DM, M / 256, 2 * DFF / 256, DM, true); }
    { pg8::EpiF16 e{KMEM, DM, 1.f, 0}; DENSE(pg8::EpiF16, e, MEMN, DM, (u16*)(ws + WS_WKV), DM, BATCH * NMEM / 256, DM / 256, DM, true); }
    for (int b = 0; b < BATCH; ++b) { pg8::EpiF16 e{VMEMT + (size_t)b * DM * NMEM, NMEM, 1.f, 0}; DENSE(pg8::EpiF16, e, (u16*)(ws + WS_WKV) + (size_t)DM * DM, DM, MEMN + (size_t)b * NMEM * DM, DM, DM / 256, NMEM / 256, DM, true); }
    GSYNC();
    { pg8::EpiF32 e{F32A, DM}; DENSE(pg8::EpiF32, e, ACT, DFF, (u16*)(ws + WS_W1D), DFF, M / 256, DM / 256, DFF, false); }
    GSYNC();
    nv_rownorm(gw, NGW, lane, F32A, P.in[0], 0.5f, P.in[6], OUT, P.in[7], XN);
    GSYNC();
    { pg8::EpiF16 e{PROJ, DIN, QSCALE, 2}; DENSE(pg8::EpiF16, e, XN, DM, (u16*)(ws + WS_WIN), DM, M / 256, DIN / 256, DM, true); }
    GSYNC();
    nv_kmean(gw, NGW, lane, PROJ, KMEAN);
    GSYNC();
    { const int vcu = ((int)blockIdx.x % 8) * (G / 8) + (int)blockIdx.x / 8, bh = vcu >> 3, sidx = vcu & 7;
      static_assert(moba::LDS_BYTES <= 131072, "attention LDS");
      moba::attn_unit<8>(bh / NH, bh % NH, sidx, PROJ, KMEAN, MIX, (char*)lds, wave);
      moba::attn_unit<8>(bh / NH, bh % NH, 15 - sidx, PROJ, KMEAN, MIX, (char*)lds, wave); }
    for (int pu = (int)blockIdx.x; pu < (M / 256) * 4; pu += G) poolu::pool_unit(pu >> 2, pu & 3, PROJ, (const u16*)(ws + WS_WPT), P.in[10], MIX, lds, wave);
    GSYNC();
    { pg8::EpiF32 e{F32B, DM}; DENSE(pg8::EpiF32, e, MIX, DM, (u16*)(ws + WS_WOUT), DM, M / 256, DM / 256, DM, false); }
    GSYNC();
    nv_rownorm(gw, NGW, lane, F32B, OUT, 1.0f, P.in[12], OUT, P.in[13], XN);
    GSYNC();
    { pg8::EpiF16 e{XQ, DM, XQSCALE, 4}; DENSE(pg8::EpiF16, e, XN, DM, (u16*)(ws + WS_WQ), DM, M / 256, DM / 256, DM, false); }
    asm volatile("s_waitcnt vmcnt(0)" ::: "memory"); __syncthreads();
    { pg8::EpiSoftmax e{XP, DM}; pg8::XOrder S_; S_.init(M / 256, XH, G, (int)blockIdx.x); S_.A = XQ; S_.B = KMEM; S_.lda = DM; S_.bb = (size_t)NMEM * DM; S_.bh = XHD;
      pg8::gemm_phase<pg8::EpiSoftmax, pg8::XOrder, false, true>(ldsl, pg8::Gemm{XHD, DM, DM}, S_, e, wave); }
    asm volatile("s_waitcnt vmcnt(0)" ::: "memory"); __syncthreads();
    { pg8::EpiF16 e{XAO, DM, 1.f, 0}; pg8::XOrder S_; S_.init(M / 256, XH, G, (int)blockIdx.x); S_.A = XP; S_.B = VMEMT; S_.lda = DM; S_.bb = (size_t)DM * NMEM; S_.bh = (size_t)XHD * NMEM;
      pg8::gemm_phase<pg8::EpiF16, pg8::XOrder, false, true>(ldsl, pg8::Gemm{NMEM, DM, NMEM}, S_, e, wave); }
    GSYNC();
    { pg8::EpiF32 e{F32B, DM}; DENSE(pg8::EpiF32, e, XAO, DM, (u16*)(ws + WS_WO), DM, M / 256, DM / 256, DM, false); }
    GSYNC();
    nv_rownorm(gw, NGW, lane, F32B, OUT, 1.0f, P.in[18], OUT, P.in[19], XN);
    GSYNC();
    { pg8::EpiSwiGLU e{ACT, DFF}; DENSE(pg8::EpiSwiGLU, e, XN, DM, (u16*)(ws + WS_W2A), DM, M / 256, 2 * DFF / 256, DM, true); }
    GSYNC();
    { pg8::EpiF32 e{F32A, DM}; DENSE(pg8::EpiF32, e, ACT, DFF, (u16*)(ws + WS_W2D), DFF, M / 256, DM / 256, DFF, false); }
    GSYNC();
    nv_rownorm(gw, NGW, lane, F32A, OUT, 0.5f, P.in[23], OUT, nullptr, nullptr);
#undef lane
}

extern "C" void kernel_launch(void* const* d_in, const int* in_sizes, int n_in, void* d_out, int out_size, void* d_ws, size_t ws_size, hipStream_t stream) {
    static int grid = 0;
    if (grid == 0) {
        if (n_in != 24 || out_size != M * DM || ws_size < WS_END) { fprintf(stderr, "kernel_launch: unexpected shapes (n_in %d out %d ws %zu)\n", n_in, out_size, ws_size); grid = -1; return; }
        int dev = 0, cus = 0, per_cu = 0;
        if (hipGetDevice(&dev) != hipSuccess || hipDeviceGetAttribute(&cus, hipDeviceAttributeMultiprocessorCount, dev) != hipSuccess) { grid = -1; return; }
        if (hipFuncSetAttribute((const void*)mega, hipFuncAttributeMaxDynamicSharedMemorySize, LDS_BYTES) != hipSuccess) { fprintf(stderr, "kernel_launch: hipFuncSetAttribute failed\n"); grid = -1; return; }
        if (hipOccupancyMaxActiveBlocksPerMultiprocessor(&per_cu, (const void*)mega, NTHREADS, LDS_BYTES) != hipSuccess || per_cu < 1) { fprintf(stderr, "kernel_launch: occupancy query failed (%d)\n", per_cu); grid = -1; return; }
        grid = cus * 1;
        fprintf(stderr, "kernel_launch: %d CUs, occupancy %d/CU, grid %d\n", cus, per_cu, grid);
    }
    if (grid < 0) return;
    (void)hipMemsetAsync((unsigned char*)d_ws + WS_CTL, 0, CTL_BYTES, stream);
    Args a{};
    for (int i = 0; i < 24; ++i) a.p.in[i] = (const float*)d_in[i];
    a.p.out = (float*)d_out; a.p.ws = (unsigned char*)d_ws;
    void* kargs[] = {&a};
    hipError_t e = hipLaunchCooperativeKernel((const void*)mega, dim3(grid), dim3(NTHREADS), kargs, LDS_BYTES, stream);
    if (e != hipSuccess) fprintf(stderr, "kernel_launch: cooperative launch failed: %s (grid %d)\n", hipGetErrorString(e), grid);
}
```

```cpp
#include <hip/hip_runtime.h>
#include <hip/hip_cooperative_groups.h>
#include <cstdio>
#include <cstdint>

typedef unsigned short u16;
typedef _Float16 h8 __attribute__((ext_vector_type(8)));
typedef _Float16 h2 __attribute__((ext_vector_type(2)));
typedef float f32x2 __attribute__((ext_vector_type(2)));
typedef float f32x4 __attribute__((ext_vector_type(4)));
typedef float f32x16 __attribute__((ext_vector_type(16)));
typedef unsigned u32x4 __attribute__((ext_vector_type(4)));
typedef unsigned u32x2 __attribute__((ext_vector_type(2)));

constexpr int BATCH = 4, SEQ = 4096, DM = 1024, M = BATCH * SEQ;
constexpr int NH = 8, HD = 64, DATT = 512, DPOOL = 512, DIN = 2048;
constexpr int LBLK = 256, NBLK = SEQ / LBLK;
constexpr int NMEM = 256, XH = 4, XHD = 256;
constexpr int DFF = 2816;
constexpr float EPS = 1e-6f;
constexpr float LOG2E = 1.4426950408889634f;
constexpr float QSCALE = 0.125f * LOG2E;
constexpr float XQSCALE = 0.0625f * LOG2E;

constexpr size_t MiB = 1u << 20;
constexpr size_t WS_CTL = 0, CTL_BYTES = 1 * MiB;
constexpr size_t WS_KMEAN = 1 * MiB;
constexpr size_t WS_XBUF = 2 * MiB;
constexpr size_t WS_MEMN = 5 * MiB;
constexpr size_t WS_KMEM = 7 * MiB;
constexpr size_t WS_VMEMT = 9 * MiB;
constexpr size_t WS_WPT = 11 * MiB;
constexpr size_t WS_W1A = 12 * MiB;
constexpr size_t WS_W1D = 23 * MiB;
constexpr size_t WS_W2A = WS_W1D + 5 * MiB + MiB / 2;
constexpr size_t WS_W2D = WS_W2A + 11 * MiB;
constexpr size_t WS_WIN = 45 * MiB;
constexpr size_t WS_WOUT = 49 * MiB;
constexpr size_t WS_WQ = 51 * MiB;
constexpr size_t WS_WKV = 53 * MiB;
constexpr size_t WS_WO = 57 * MiB;
constexpr size_t WS_XN = 60 * MiB;
constexpr size_t WS_R1 = 92 * MiB;
constexpr size_t WS_ACT = WS_R1, WS_PROJ = WS_R1, WS_XQ = WS_R1, WS_XP = WS_R1 + 32 * MiB, WS_F32B = WS_R1;
constexpr size_t WS_R2 = 180 * MiB;
constexpr size_t WS_MIX = WS_R2, WS_XAO = WS_R2 + 32 * MiB, WS_F32A = WS_R2;
constexpr size_t WS_END = 244 * MiB;

__device__ __forceinline__ float h2f(u16 v) { return (float)__builtin_bit_cast(_Float16, v); }
__device__ __forceinline__ u16 f2h(float f) { return __builtin_bit_cast(u16, (_Float16)f); }
__device__ __forceinline__ unsigned pk2h(float lo, float hi) { f32x2 v = {lo, hi}; h2 h = __builtin_convertvector(v, h2); return __builtin_bit_cast(unsigned, h); }
__device__ __forceinline__ float wave_sum(float v) {
#pragma unroll
    for (int o = 1; o < 64; o <<= 1) v += __shfl_xor(v, o);
    return v;
}
__device__ __forceinline__ float wave_max(float v) {
#pragma unroll
    for (int o = 1; o < 64; o <<= 1) v = fmaxf(v, __shfl_xor(v, o));
    return v;
}

__device__ __forceinline__ int fresh_lane() { int l; asm volatile("v_mbcnt_lo_u32_b32 %0, -1, 0\n\tv_mbcnt_hi_u32_b32 %0, -1, %0" : "=v"(l)); return l; }

struct Ptrs {
    const float* in[24];
    float* out;
    unsigned char* ws;
};

__device__ __forceinline__ int rowmap(int map, int n) { return map == 0 ? n : ((n >> 7) * 256 + (map == 2 ? 128 : 0) + (n & 127)); }
__device__ __forceinline__ void transpose_item(const float* W, int K, int N, u16* WT, int map, float* scr, int item, int lane) {
    const int nblk = N / 32, kb = item / nblk, nb = item % nblk, k0 = 64 * kb, n0 = 32 * nb;
#pragma unroll 8
    for (int i = 0; i < 32; ++i) { const int kk = 2 * i + (lane >> 5); scr[kk * 33 + (lane & 31)] = W[(size_t)(k0 + kk) * N + n0 + (lane & 31)]; }
    asm volatile("s_waitcnt lgkmcnt(0)" ::: "memory");
    const int c = lane & 7;
    const int r0 = rowmap(map, n0);
#pragma unroll
    for (int j = 0; j < 4; ++j) { const int n = (lane >> 3) + 8 * j; const float* s = scr + (8 * c) * 33 + n;
        u32x4 o; o.x = pk2h(s[0 * 33], s[1 * 33]); o.y = pk2h(s[2 * 33], s[3 * 33]); o.z = pk2h(s[4 * 33], s[5 * 33]); o.w = pk2h(s[6 * 33], s[7 * 33]);
        *(u32x4*)(WT + (size_t)(r0 + n) * K + k0 + 8 * c) = o; }
    asm volatile("s_waitcnt lgkmcnt(0)" ::: "memory");
}
__device__ __forceinline__ void rms_row_to_f16(const float* xrow, const float* g, u16* orow, int lane) {
    const f32x4* xr = (const f32x4*)xrow + lane; const f32x4* gr = (const f32x4*)g + lane;
    f32x4 v[4]; float s = 0.f;
#pragma unroll
    for (int j = 0; j < 4; ++j) { v[j] = xr[64 * j]; s += (v[j].x * v[j].x + v[j].y * v[j].y) + (v[j].z * v[j].z + v[j].w * v[j].w); }
    const float r = 1.0f / sqrtf(wave_sum(s) * (1.f / DM) + EPS);
    u32x2* o8 = (u32x2*)orow + lane;
#pragma unroll
    for (int j = 0; j < 4; ++j) { const f32x4 gg = gr[64 * j]; u32x2 w; w.x = pk2h(v[j].x * r * gg.x, v[j].y * r * gg.y); w.y = pk2h(v[j].z * r * gg.z, v[j].w * r * gg.w); o8[64 * j] = w; }
}
struct TItem { int idx, K, N; size_t dst; int map; };
__device__ __forceinline__ void prologue(const Ptrs& P, int gw, int NGW, int lane, float* scr) {
    unsigned char* ws = P.ws;
    constexpr int I_UP = 16 * 88, I_DN = 44 * 32, I_IN = 16 * 64, I_SQ = 16 * 32, I_PW = 8 * 4;
    constexpr int NITEMS = 4 * I_UP + 2 * I_DN + 2 * I_IN + 3 * I_SQ + I_PW;
    for (int it = gw; it < NITEMS; it += NGW) {
        int r = it;
        if (r < I_UP) { transpose_item(P.in[3], 1024, DFF, (u16*)(ws + WS_W1A), 1, scr, r, lane); continue; } r -= I_UP;
        if (r < I_UP) { transpose_item(P.in[4], 1024, DFF, (u16*)(ws + WS_W1A), 2, scr, r, lane); continue; } r -= I_UP;
        if (r < I_DN) { transpose_item(P.in[5], DFF, 1024, (u16*)(ws + WS_W1D), 0, scr, r, lane); continue; } r -= I_DN;
        if (r < I_UP) { transpose_item(P.in[20], 1024, DFF, (u16*)(ws + WS_W2A), 1, scr, r, lane); continue; } r -= I_UP;
        if (r < I_UP) { transpose_item(P.in[21], 1024, DFF, (u16*)(ws + WS_W2A), 2, scr, r, lane); continue; } r -= I_UP;
        if (r < I_DN) { transpose_item(P.in[22], DFF, 1024, (u16*)(ws + WS_W2D), 0, scr, r, lane); continue; } r -= I_DN;
        if (r < I_IN) { transpose_item(P.in[8], 1024, DIN, (u16*)(ws + WS_WIN), 0, scr, r, lane); continue; } r -= I_IN;
        if (r < I_IN) { transpose_item(P.in[16], 1024, 2048, (u16*)(ws + WS_WKV), 0, scr, r, lane); continue; } r -= I_IN;
        if (r < I_SQ) { transpose_item(P.in[11], 1024, 1024, (u16*)(ws + WS_WOUT), 0, scr, r, lane); continue; } r -= I_SQ;
        if (r < I_SQ) { transpose_item(P.in[15], 1024, 1024, (u16*)(ws + WS_WQ), 0, scr, r, lane); continue; } r -= I_SQ;
        if (r < I_SQ) { transpose_item(P.in[17], 1024, 1024, (u16*)(ws + WS_WO), 0, scr, r, lane); continue; } r -= I_SQ;
        transpose_item(P.in[9], 512, 128, (u16*)(ws + WS_WPT), 0, scr, r, lane);
    }
    for (int m = gw; m < M; m += NGW) rms_row_to_f16(P.in[0] + (size_t)m * DM, P.in[2], (u16*)(ws + WS_XN) + (size_t)m * DM, lane);
    for (int m = gw; m < BATCH * NMEM; m += NGW) rms_row_to_f16(P.in[1] + (size_t)m * DM, P.in[14], (u16*)(ws + WS_MEMN) + (size_t)m * DM, lane);
    float* km = (float*)(ws + WS_KMEAN);
    for (int i = gw * 64 + lane; i < BATCH * NBLK * 512; i += NGW * 64) km[i] = 0.f;
}

template <int MODE>
__device__ __forceinline__ void nv_gemm(int gw, int NGW, int lane, const u16* A, int lda, const u16* Bt, int ldb, int Mr, int N, int K, void* C, int ldc, float sc, int sccols) {
    const int r = lane & 31, h = lane >> 5, ntn = N / 32, ntiles = (Mr / 32) * ntn;
    for (int wt = gw; wt < ntiles; wt += NGW) {
        const int m0 = (wt / ntn) * 32, n0 = (wt % ntn) * 32;
        const u16* ap = A + (size_t)(m0 + r) * lda + 8 * h;
        if (MODE == 2) {
            const int rg = (n0 >> 7) * 256 + (n0 & 127), ru = rg + 128;
            f32x16 ag = {}, au = {};
            const u16* bg = Bt + (size_t)(rg + r) * ldb + 8 * h;
            const u16* bu = Bt + (size_t)(ru + r) * ldb + 8 * h;
            for (int k = 0; k < K; k += 16) {
                const h8 a = *(const h8*)(ap + k), g = *(const h8*)(bg + k), u = *(const h8*)(bu + k);
                ag = __builtin_amdgcn_mfma_f32_32x32x16_f16(a, g, ag, 0, 0, 0);
                au = __builtin_amdgcn_mfma_f32_32x32x16_f16(a, u, au, 0, 0, 0);
            }
#pragma unroll
            for (int i = 0; i < 16; ++i) { const int row = m0 + (i & 3) + 8 * (i >> 2) + 4 * h, col = n0 + r;
                const float gv = ag[i], uv = au[i]; const float sg = gv / (1.f + __expf(-gv));
                ((u16*)C)[(size_t)row * ldc + col] = f2h(sg * uv); }
        } else {
            f32x16 acc = {};
            const u16* bp = Bt + (size_t)(n0 + r) * ldb + 8 * h;
            for (int k = 0; k < K; k += 16) {
                const h8 a = *(const h8*)(ap + k), b = *(const h8*)(bp + k);
                acc = __builtin_amdgcn_mfma_f32_32x32x16_f16(a, b, acc, 0, 0, 0);
            }
#pragma unroll
            for (int i = 0; i < 16; ++i) { const int row = m0 + (i & 3) + 8 * (i >> 2) + 4 * h, col = n0 + r;
                if (MODE == 0) ((u16*)C)[(size_t)row * ldc + col] = f2h(acc[i] * (col < sccols ? sc : 1.f));
                else ((float*)C)[(size_t)row * ldc + col] = acc[i]; }
        }
    }
}
__device__ __forceinline__ void nv_rownorm(int gw, int NGW, int lane, const float* F, const float* base, float w, const float* gpost, float* out, const float* gnext, u16* XN) {
    for (int row = gw; row < M; row += NGW) {
        const f32x4* fr = (const f32x4*)(F + (size_t)row * DM) + lane; const f32x4* br = (const f32x4*)(base + (size_t)row * DM) + lane;
        const f32x4* gp = (const f32x4*)gpost + lane;
        f32x4 f[4], x[4]; float s = 0.f;
#pragma unroll
        for (int j = 0; j < 4; ++j) { f[j] = fr[64 * j]; x[j] = br[64 * j]; s += (f[j].x * f[j].x + f[j].y * f[j].y) + (f[j].z * f[j].z + f[j].w * f[j].w); }
        const float r = 1.0f / sqrtf(wave_sum(s) * (1.f / DM) + EPS);
        float s2 = 0.f;
#pragma unroll
        for (int j = 0; j < 4; ++j) { const f32x4 g = gp[64 * j]; x[j] = x[j] + w * ((f[j] * r) * g); s2 += (x[j].x * x[j].x + x[j].y * x[j].y) + (x[j].z * x[j].z + x[j].w * x[j].w); }
        f32x4* orow = (f32x4*)(out + (size_t)row * DM) + lane;
#pragma unroll
        for (int j = 0; j < 4; ++j) orow[64 * j] = x[j];
        if (XN) {
            const float r2 = 1.0f / sqrtf(wave_sum(s2) * (1.f / DM) + EPS);
            const f32x4* gn = (const f32x4*)gnext + lane; u32x2* o8 = (u32x2*)(XN + (size_t)row * DM) + lane;
#pragma unroll
            for (int j = 0; j < 4; ++j) { const f32x4 g = gn[64 * j]; u32x2 o; o.x = pk2h(x[j].x * r2 * g.x, x[j].y * r2 * g.y); o.y = pk2h(x[j].z * r2 * g.z, x[j].w * r2 * g.w); o8[64 * j] = o; }
        }
    }
}
__device__ __forceinline__ void nv_kmean(int gw, int NGW, int lane, const u16* PROJ, float* KMEAN) {
    for (int i = gw * 64 + lane; i < BATCH * NBLK * 512; i += NGW * 64) { const int bb = i >> 9, c = i & 511; float s = 0.f;
        for (int r = 0; r < LBLK; ++r) s += h2f(PROJ[(size_t)(bb * LBLK + r) * DIN + 512 + c]);
        KMEAN[i] = s * (1.f / LBLK); }
}
__device__ __forceinline__ void nv_moba(int gw, int NGW, int lane, float* wl, const u16* PROJ, const float* KMEAN, u16* MIX) {
    float* sq = wl; float* sp = wl + 64;
    for (int gq = gw; gq < BATCH * NH * SEQ; gq += NGW) {
        const int t = gq % SEQ, h = (gq / SEQ) % NH, b = gq / (SEQ * NH);
        const size_t row = (size_t)b * SEQ + t;
        const int own = t / LBLK;
        const float qd = h2f(PROJ[row * DIN + h * HD + lane]);
        sq[lane] = qd;
        float v1 = -INFINITY, v2 = -INFINITY, v3 = -INFINITY; int i1 = -1, i2 = -1, i3 = -1;
        for (int n = 0; n < own; ++n) {
            const float g = wave_sum(qd * KMEAN[((size_t)b * NBLK + n) * 512 + h * HD + lane]);
            if (g > v1) { v3 = v2; i3 = i2; v2 = v1; i2 = i1; v1 = g; i1 = n; }
            else if (g > v2) { v3 = v2; i3 = i2; v2 = g; i2 = n; }
            else if (g > v3) { v3 = g; i3 = n; }
        }
        const float slope2 = exp2f(-(float)(h + 1)) * LOG2E;
        int blks[4] = {i1, i2, i3, own};
        float s[16]; float mx = -INFINITY;
#pragma unroll
        for (int sl = 0; sl < 4; ++sl) {
            const int blk = blks[sl];
#pragma unroll
            for (int c = 0; c < 4; ++c) {
                float sc = -INFINITY;
                if (blk >= 0) {
                    const int kpos = blk * LBLK + c * 64 + lane;
                    if (kpos <= t) {
                        const u16* kr = PROJ + ((size_t)b * SEQ + kpos) * DIN + 512 + h * HD; float a = 0.f;
#pragma unroll 2
                        for (int d = 0; d < 64; d += 8) { const h8 kv = *(const h8*)(kr + d);
#pragma unroll
                            for (int j = 0; j < 8; ++j) a += sq[d + j] * (float)kv[j]; }
                        sc = a - slope2 * (float)(t - kpos);
                    }
                }
                s[sl * 4 + c] = sc; mx = fmaxf(mx, sc);
            }
        }
        mx = wave_max(mx);
        float l = 0.f;
#pragma unroll
        for (int i = 0; i < 16; ++i) { const float p = exp2f(s[i] - mx); l += p; sp[i * 64 + lane] = p; }
        l = wave_sum(l);
        float o = 0.f;
#pragma unroll
        for (int sl = 0; sl < 4; ++sl) {
            const int blk = blks[sl];
            if (blk >= 0) {
                const u16* vb = PROJ + ((size_t)b * SEQ + blk * LBLK) * DIN + 1024 + h * HD + lane;
                for (int j = 0; j < LBLK; ++j) o += sp[sl * 256 + j] * h2f(vb[(size_t)j * DIN]);
            }
        }
        MIX[row * DM + h * HD + lane] = f2h(o / l);
    }
}
__device__ __forceinline__ void nv_pool(int gw, int NGW, int lane, float* wl, const u16* PROJ, const float* pool_w, const float* pool_scale, u16* MIX) {
    for (int it = gw; it < M * 4; it += NGW) {
        const int g = it & 3; const size_t row = it >> 2; const int t = (int)(row % SEQ);
        const int w = 2 << g, lo = max(t + 1 - w, 0), cnt = t + 1 - lo;
#pragma unroll
        for (int hh = 0; hh < 2; ++hh) { const int c = lane + 64 * hh; float s = 0.f;
            for (int j = lo; j <= t; ++j) s += h2f(PROJ[(row - (t - j)) * DIN + 1536 + g * 128 + c]);
            wl[c] = s / (float)cnt - h2f(PROJ[row * DIN + 1536 + g * 128 + c]); }
        float y0 = 0.f, y1 = 0.f;
        for (int k = 0; k < 128; ++k) { const float d = wl[k]; y0 += d * pool_w[((size_t)g * 128 + k) * 128 + lane]; y1 += d * pool_w[((size_t)g * 128 + k) * 128 + lane + 64]; }
        MIX[row * DM + 512 + g * 128 + lane] = f2h(y0 * pool_scale[g * 128 + lane]);
        MIX[row * DM + 512 + g * 128 + lane + 64] = f2h(y1 * pool_scale[g * 128 + lane + 64]);
    }
}
__device__ __forceinline__ void nv_xattn(int gw, int NGW, int lane, float* wl, const u16* XQ, const u16* KMEM, const u16* VMEMT, u16* XAO) {
    float* sq = wl; float* sp = wl + 256;
    for (int gi = gw; gi < M * XH; gi += NGW) {
        const int h = gi & 3; const size_t row = gi >> 2; const int b = (int)(row / SEQ);
#pragma unroll
        for (int j = 0; j < 4; ++j) sq[j * 64 + lane] = h2f(XQ[row * DM + h * XHD + j * 64 + lane]);
        float s[4]; float mx = -INFINITY;
#pragma unroll
        for (int j = 0; j < 4; ++j) { const int m = j * 64 + lane; const u16* kr = KMEM + ((size_t)b * NMEM + m) * DM + h * XHD; float a = 0.f;
#pragma unroll 2
            for (int d = 0; d < 256; d += 8) { const h8 kv = *(const h8*)(kr + d);
#pragma unroll
                for (int i = 0; i < 8; ++i) a += sq[d + i] * (float)kv[i]; }
            s[j] = a; mx = fmaxf(mx, a); }
        mx = wave_max(mx); float l = 0.f;
#pragma unroll
        for (int j = 0; j < 4; ++j) { const float p = exp2f(s[j] - mx); l += p; sp[j * 64 + lane] = p; }
        l = wave_sum(l);
#pragma unroll
        for (int j = 0; j < 4; ++j) { const int d = j * 64 + lane; const u16* vr = VMEMT + ((size_t)b * DM + h * XHD + d) * NMEM; float o = 0.f;
#pragma unroll 2
            for (int m = 0; m < 256; m += 8) { const h8 vv = *(const h8*)(vr + m);
#pragma unroll
                for (int i = 0; i < 8; ++i) o += sp[m + i] * (float)vv[i]; }
            XAO[row * DM + h * XHD + d] = f2h(o / l); }
    }
}

namespace pg8 {
#define PG8_LAS __attribute__((address_space(3)))
constexpr int BM = 256, BK = 64, HALF = 128, HTB = HALF * BK * 2, STAGE_BYTES = 8 * HTB, NXCD = 8, WGM = 8;
__host__ __device__ __forceinline__ int lds_byte(int r, int c) { const int st = (r >> 4) * 2 + (c >> 5), rr = r & 15, cc = c & 31, ob = rr * 64 + cc * 2; return st * 1024 + (ob ^ (((ob >> 9) & 1) << 5)); }
__host__ __device__ __forceinline__ void stage_rc(int b, int& R, int& C) { const int st = b / 1024, sb = b % 1024, swz = sb ^ (((sb >> 9) & 1) << 5); R = (st >> 1) * 16 + swz / 64; C = (st & 1) * 32 + (swz % 64) / 2; }
__host__ __device__ __forceinline__ int perm32(int rho) { const int n = rho >> 4, i = rho & 15; return 8 * (i >> 2) + 4 * n + (i & 3); }

struct Unit { int pm, pn; const char* a; const char* b; };
struct Gemm { int K, lda, ldb; };

struct GridOrder {
    int nM, nN, nwg, G, c;
    __device__ void init(int nM_, int nN_, int G_, int c_) { nM = nM_; nN = nN_; nwg = nM * nN; G = G_; c = c_; }
    __device__ bool tile(int i, int& pm, int& pn) const {
        const long L = (long)i * G + c; if (L >= nwg) return false;
        int wgid = (int)L; { const int q = nwg / NXCD, r = nwg % NXCD, xcd = wgid % NXCD, off = wgid / NXCD; wgid = (xcd < r ? xcd * (q + 1) : r * (q + 1) + (xcd - r) * q) + off; }
        const int nig = WGM * nN, gid = wgid / nig, fm = gid * WGM, gsz = (nM - fm) < WGM ? (nM - fm) : WGM;
        pm = fm + ((wgid % nig) % gsz); pn = (wgid % nig) / gsz; return true;
    }
};
struct DenseOrder : GridOrder {
    const u16* A; const u16* Bt; int lda, ldb;
    __device__ bool next(int i, Unit& u) const { if (!tile(i, u.pm, u.pn)) return false; u.a = (const char*)(A + (size_t)u.pm * BM * lda); u.b = (const char*)(Bt + (size_t)u.pn * BM * ldb); return true; }
};

struct EpiF32 {
    static constexpr bool PERM = false, AFTER_DRAIN = false;
    float* C; int ldc;
    __device__ __forceinline__ void operator()(const f32x4 (&acc)[2][2][4][2], const Unit& u, int wr, int wc, int fr, int fq) const {
        const int row0 = u.pm * BM + wr * 64 + fr, col0 = u.pn * BM + wc * 32 + 4 * fq;
#pragma unroll
        for (int ai = 0; ai < 2; ++ai)
#pragma unroll
            for (int m = 0; m < 4; ++m) { float* rowp = C + (size_t)(row0 + ai * HALF + m * 16) * ldc + col0;
#pragma unroll
                for (int bj = 0; bj < 2; ++bj)
#pragma unroll
                    for (int n = 0; n < 2; ++n) *(f32x4*)(rowp + bj * HALF + n * 16) = acc[ai][bj][m][n]; }
    }
};
struct EpiF16 {
    static constexpr bool PERM = true, AFTER_DRAIN = false;
    u16* O; int ldc; float scale0; int sctiles;
    __device__ __forceinline__ void operator()(const f32x4 (&acc)[2][2][4][2], const Unit& u, int wr, int wc, int fr, int fq) const {
        const int row0 = u.pm * BM + wr * 64 + fr, col0 = u.pn * BM + wc * 32 + 8 * fq;
        const float sc = u.pn < sctiles ? scale0 : 1.f;
#pragma unroll
        for (int ai = 0; ai < 2; ++ai)
#pragma unroll
            for (int m = 0; m < 4; ++m) { u16* rowp = O + (size_t)(row0 + ai * HALF + m * 16) * ldc + col0;
#pragma unroll
                for (int bj = 0; bj < 2; ++bj) { const f32x4 v0 = acc[ai][bj][m][0] * sc, v1 = acc[ai][bj][m][1] * sc;
                    u32x4 w; w.x = pk2h(v0[0], v0[1]); w.y = pk2h(v0[2], v0[3]); w.z = pk2h(v1[0], v1[1]); w.w = pk2h(v1[2], v1[3]);
                    *(u32x4*)(rowp + bj * HALF) = w; } }
    }
};
__device__ __forceinline__ float silu_mul(float g, float u) { return g * u * __builtin_amdgcn_rcpf(1.f + __builtin_amdgcn_exp2f(-LOG2E * g)); }
struct EpiSwiGLU {
    static constexpr bool PERM = true, AFTER_DRAIN = false;
    u16* O; int ldc;
    __device__ __forceinline__ void operator()(const f32x4 (&acc)[2][2][4][2], const Unit& u, int wr, int wc, int fr, int fq) const {
        const int row0 = u.pm * BM + wr * 64 + fr, col0 = u.pn * HALF + wc * 32 + 8 * fq;
#pragma unroll
        for (int ai = 0; ai < 2; ++ai)
#pragma unroll
            for (int m = 0; m < 4; ++m) { u16* rowp = O + (size_t)(row0 + ai * HALF + m * 16) * ldc + col0;
                const f32x4 g0 = acc[ai][0][m][0], g1 = acc[ai][0][m][1], u0 = acc[ai][1][m][0], u1 = acc[ai][1][m][1];
                u32x4 w; w.x = pk2h(silu_mul(g0[0], u0[0]), silu_mul(g0[1], u0[1])); w.y = pk2h(silu_mul(g0[2], u0[2]), silu_mul(g0[3], u0[3]));
                w.z = pk2h(silu_mul(g1[0], u1[0]), silu_mul(g1[1], u1[1])); w.w = pk2h(silu_mul(g1[2], u1[2]), silu_mul(g1[3], u1[3]));
                *(u32x4*)rowp = w; }
    }
};

struct XOrder : GridOrder {
    const u16* A; const u16* B; int lda; size_t bb, bh;
    __device__ bool next(int i, Unit& u) const { if (!tile(i, u.pm, u.pn)) return false;
        u.a = (const char*)(A + (size_t)u.pm * BM * lda + (size_t)u.pn * BM); u.b = (const char*)(B + (size_t)(u.pm >> 4) * bb + (size_t)u.pn * bh); return true; }
};
struct EpiSoftmax {
    static constexpr bool PERM = true, AFTER_DRAIN = true;
    u16* O; int ldc;
    __device__ __forceinline__ void fused(f32x4 (&acc)[2][2][4][2], const Unit& u, int wr, int wc, int fr, int fq, PG8_LAS unsigned char* lds, int wid, int lane) const {
        PG8_LAS float* P1 = (PG8_LAS float*)lds; PG8_LAS float* P2 = (PG8_LAS float*)(lds + 4096);
#pragma unroll
        for (int ai = 0; ai < 2; ++ai)
#pragma unroll
            for (int m = 0; m < 4; ++m) { float mx = -INFINITY;
#pragma unroll
                for (int bj = 0; bj < 2; ++bj)
#pragma unroll
                    for (int n = 0; n < 2; ++n) { const f32x4 x = acc[ai][bj][m][n]; mx = fmaxf(mx, fmaxf(fmaxf(x[0], x[1]), fmaxf(x[2], x[3]))); }
                mx = fmaxf(mx, __shfl_xor(mx, 16)); mx = fmaxf(mx, __shfl_xor(mx, 32));
                if (fq == 0) P1[(ai * HALF + wr * 64 + m * 16 + fr) * 4 + wc] = mx; }
        asm volatile("s_waitcnt lgkmcnt(0)" ::: "memory"); __builtin_amdgcn_s_barrier(); asm volatile("" ::: "memory");
#pragma unroll
        for (int ai = 0; ai < 2; ++ai)
#pragma unroll
            for (int m = 0; m < 4; ++m) { const int row = ai * HALF + wr * 64 + m * 16 + fr; const f32x4 q = *(const PG8_LAS f32x4*)(P1 + row * 4);
                const float rm = fmaxf(fmaxf(q[0], q[1]), fmaxf(q[2], q[3])); float sm = 0.f;
#pragma unroll
                for (int bj = 0; bj < 2; ++bj)
#pragma unroll
                    for (int n = 0; n < 2; ++n) { f32x4 x = acc[ai][bj][m][n];
                        x[0] = __builtin_amdgcn_exp2f(x[0] - rm); x[1] = __builtin_amdgcn_exp2f(x[1] - rm); x[2] = __builtin_amdgcn_exp2f(x[2] - rm); x[3] = __builtin_amdgcn_exp2f(x[3] - rm);
                        sm += (x[0] + x[1]) + (x[2] + x[3]); acc[ai][bj][m][n] = x; }
                sm += __shfl_xor(sm, 16); sm += __shfl_xor(sm, 32);
                if (fq == 0) P2[row * 4 + wc] = sm; }
        asm volatile("s_waitcnt lgkmcnt(0)" ::: "memory"); __builtin_amdgcn_s_barrier(); asm volatile("" ::: "memory");
        const int row0 = u.pm * BM + wr * 64 + fr, col0 = u.pn * BM + wc * 32 + 8 * fq;
#pragma unroll
        for (int ai = 0; ai < 2; ++ai)
#pragma unroll
            for (int m = 0; m < 4; ++m) { const int row = ai * HALF + wr * 64 + m * 16 + fr; const f32x4 q = *(const PG8_LAS f32x4*)(P2 + row * 4);
                const float inv = 1.0f / ((q[0] + q[1]) + (q[2] + q[3]));
                u16* rowp = O + (size_t)(row0 + ai * HALF + m * 16) * ldc + col0;
#pragma unroll
                for (int bj = 0; bj < 2; ++bj) { const f32x4 v0 = acc[ai][bj][m][0] * inv, v1 = acc[ai][bj][m][1] * inv;
                    u32x4 w; w.x = pk2h(v0[0], v0[1]); w.y = pk2h(v0[2], v0[3]); w.z = pk2h(v1[0], v1[1]); w.w = pk2h(v1[2], v1[3]);
                    *(u32x4*)(rowp + bj * HALF) = w; } }
        asm volatile("s_waitcnt lgkmcnt(0)" ::: "memory"); __builtin_amdgcn_s_barrier(); asm volatile("" ::: "memory");
    }
};

template <class Epi, class Sched, bool ALIGN_EPI = false, bool SP2 = false>
__device__ __forceinline__ void gemm_phase(PG8_LAS unsigned char* lds, const Gemm g, const Sched& S, const Epi& E, const int wid) {
    const int lane = fresh_lane(), tid = wid * 64 + lane, wr = wid >> 2, wc = wid & 3, fr = lane & 15, fq = lane >> 4;
    const int K = g.K, nt = K / BK;
    unsigned voffA[2], voffB[2];
#pragma unroll
    for (int i = 0; i < 2; ++i) { int R, C; stage_rc(tid * 16 + i * 8192, R, C); const int Rb = Epi::PERM ? ((R & ~31) + perm32(R & 31)) : R;
        voffA[i] = (unsigned)(R * g.lda + C) * 2u; voffB[i] = (unsigned)(Rb * g.ldb + C) * 2u; }
    const size_t kstep = (size_t)(BK * 2);
    const size_t hstepA = (size_t)HALF * g.lda * 2, hstepB = (size_t)HALF * g.ldb * 2;
    const unsigned ldsw = (unsigned)wid * 1024u;
    const int aoff = lds_byte(wr * 64 + fr, fq * 8), boff = lds_byte(wc * 32 + fr, fq * 8);
#define PG8_SA(b, h) (((b) * 2 + (h)) * HTB)
#define PG8_SB(b, h) ((4 + (b) * 2 + (h)) * HTB)
#define PG8_STAGE(bufoff, gbase, voff) do { _Pragma("unroll") for (int _i = 0; _i < 2; ++_i) \
        __builtin_amdgcn_global_load_lds((const unsigned*)((const char*)(gbase) + (voff)[_i]), (PG8_LAS unsigned*)(lds + (bufoff) + ldsw + _i * 8192), 16, 0, 0); } while (0)
#define PG8_LDA(dst, b, h) do { _Pragma("unroll") for (int m = 0; m < 4; ++m) _Pragma("unroll") for (int k = 0; k < 2; ++k) dst[m][k] = *(const PG8_LAS h8*)(lds + PG8_SA(b, h) + aoff + m * 2048 + k * 1024); } while (0)
#define PG8_LDB(dst, b, h) do { _Pragma("unroll") for (int n = 0; n < 2; ++n) _Pragma("unroll") for (int k = 0; k < 2; ++k) dst[n][k] = *(const PG8_LAS h8*)(lds + PG8_SB(b, h) + boff + n * 2048 + k * 1024); } while (0)
#define PG8_MMA(ai, bj, At, Bt) do { __builtin_amdgcn_s_setprio(1); _Pragma("unroll") for (int m = 0; m < 4; ++m) _Pragma("unroll") for (int n = 0; n < 2; ++n) _Pragma("unroll") for (int k = 0; k < 2; ++k) \
        acc[ai][bj][m][n] = __builtin_amdgcn_mfma_f32_16x16x32_f16(Bt[n][k], At[m][k], acc[ai][bj][m][n], 0, 0, 0); __builtin_amdgcn_s_setprio(0); } while (0)
#define PG8_WAIT_V(n) asm volatile("s_waitcnt vmcnt(" #n ")" ::: "memory")
#define PG8_WAIT_L(n) asm volatile("s_waitcnt lgkmcnt(" #n ")" ::: "memory")
#define PG8_BAR __builtin_amdgcn_s_barrier()
#define PG8_SCHED __builtin_amdgcn_sched_barrier(0)
    Unit cur, nxt; int ui = 0;
    if (!S.next(0, cur)) return;
    f32x4 acc[2][2][4][2];
#pragma unroll
    for (int a = 0; a < 2; ++a)
#pragma unroll
        for (int b = 0; b < 2; ++b)
#pragma unroll
            for (int m = 0; m < 4; ++m)
#pragma unroll
                for (int n = 0; n < 2; ++n) acc[a][b][m][n] = (f32x4){0.f, 0.f, 0.f, 0.f};
    h8 At[4][2], B0[2][2], B1[2][2];
    const char* cA = cur.a; const char* cB = cur.b;
    if constexpr (SP2) {
        PG8_STAGE(PG8_SB(0, 0), cB, voffB); PG8_STAGE(PG8_SB(0, 1), cB + hstepB, voffB); PG8_STAGE(PG8_SA(0, 0), cA, voffA); PG8_STAGE(PG8_SA(0, 1), cA + hstepA, voffA);
        if (wr == 1) PG8_BAR;
        PG8_WAIT_V(2); PG8_BAR;
        PG8_STAGE(PG8_SB(1, 0), cB + kstep, voffB); PG8_STAGE(PG8_SA(1, 0), cA + kstep, voffA); PG8_STAGE(PG8_SB(1, 1), cB + hstepB + kstep, voffB);
        PG8_WAIT_V(6); PG8_BAR;
    } else {
        PG8_STAGE(PG8_SB(0, 0), cB, voffB); PG8_STAGE(PG8_SA(0, 0), cA, voffA); PG8_STAGE(PG8_SB(0, 1), cB + hstepB, voffB); PG8_STAGE(PG8_SA(0, 1), cA + hstepA, voffA);
        if (wr == 1) PG8_BAR;
        PG8_WAIT_V(4); PG8_BAR;
        PG8_STAGE(PG8_SB(1, 0), cB + kstep, voffB); PG8_STAGE(PG8_SA(1, 0), cA + kstep, voffA); PG8_STAGE(PG8_SB(1, 1), cB + hstepB + kstep, voffB);
        PG8_WAIT_V(6); PG8_BAR;
    }
    for (;;) {
        const bool has_next = S.next(ui + 1, nxt);
        const char* nA = has_next ? nxt.a : cA; const char* nB = has_next ? nxt.b : cB;
        for (int t = 0; t < nt; t += 2) {
            const bool last = (t == nt - 2);
            const char* a1 = cA + (size_t)(t + 1) * kstep;
            const char* a2 = last ? nA : cA + (size_t)(t + 2) * kstep; const char* b2 = last ? nB : cB + (size_t)(t + 2) * kstep;
            const char* a3 = a2 + kstep; const char* b3 = b2 + kstep;
            if constexpr (SP2) {
            PG8_LDB(B0, 0, 0); PG8_LDB(B1, 0, 1); PG8_SCHED; PG8_LDA(At, 0, 0); PG8_STAGE(PG8_SA(1, 1), a1 + hstepA, voffA);
            PG8_WAIT_V(8); PG8_WAIT_L(0); PG8_BAR; PG8_MMA(0, 0, At, B0); PG8_MMA(0, 1, At, B1); PG8_BAR; PG8_SCHED;
            PG8_LDA(At, 0, 1); PG8_STAGE(PG8_SB(0, 0), b2, voffB); PG8_STAGE(PG8_SB(0, 1), b2 + hstepB, voffB); PG8_STAGE(PG8_SA(0, 0), a2, voffA);
            PG8_WAIT_V(8); PG8_WAIT_L(0); PG8_BAR; PG8_MMA(1, 0, At, B0); PG8_MMA(1, 1, At, B1); PG8_BAR; PG8_SCHED;
            PG8_LDB(B0, 1, 0); PG8_LDB(B1, 1, 1); PG8_SCHED; PG8_LDA(At, 1, 0); PG8_STAGE(PG8_SA(0, 1), a2 + hstepA, voffA);
            PG8_WAIT_V(8); PG8_WAIT_L(0); PG8_BAR; PG8_MMA(0, 0, At, B0); PG8_MMA(0, 1, At, B1); PG8_BAR; PG8_SCHED;
            PG8_LDA(At, 1, 1); PG8_STAGE(PG8_SB(1, 0), b3, voffB); PG8_STAGE(PG8_SB(1, 1), b3 + hstepB, voffB); PG8_STAGE(PG8_SA(1, 0), a3, voffA);
            PG8_WAIT_V(8); PG8_WAIT_L(0); PG8_BAR; PG8_MMA(1, 0, At, B0); PG8_MMA(1, 1, At, B1); PG8_BAR; PG8_SCHED;
            } else {
            PG8_LDB(B0, 0, 0); PG8_SCHED; PG8_LDA(At, 0, 0); PG8_STAGE(PG8_SA(1, 1), a1 + hstepA, voffA);
            PG8_WAIT_L(8); PG8_BAR; PG8_WAIT_L(0); PG8_MMA(0, 0, At, B0); PG8_BAR; PG8_SCHED;
            PG8_LDB(B1, 0, 1); PG8_STAGE(PG8_SB(0, 0), b2, voffB);
            PG8_BAR; PG8_WAIT_L(0); PG8_MMA(0, 1, At, B1); PG8_BAR;
            PG8_LDA(At, 0, 1); PG8_STAGE(PG8_SA(0, 0), a2, voffA);
            PG8_BAR; PG8_WAIT_L(0); PG8_MMA(1, 0, At, B0); PG8_BAR; PG8_SCHED;
            PG8_STAGE(PG8_SB(0, 1), b2 + hstepB, voffB);
            PG8_WAIT_V(6); PG8_BAR; PG8_MMA(1, 1, At, B1); PG8_BAR;
            PG8_LDB(B0, 1, 0); PG8_SCHED; PG8_LDA(At, 1, 0); PG8_STAGE(PG8_SA(0, 1), a2 + hstepA, voffA);
            PG8_WAIT_L(8); PG8_BAR; PG8_WAIT_L(0); PG8_MMA(0, 0, At, B0); PG8_BAR; PG8_SCHED;
            PG8_LDB(B1, 1, 1); PG8_STAGE(PG8_SB(1, 0), b3, voffB);
            PG8_BAR; PG8_WAIT_L(0); PG8_MMA(0, 1, At, B1); PG8_BAR;
            PG8_LDA(At, 1, 1); PG8_STAGE(PG8_SA(1, 0), a3, voffA);
            PG8_BAR; PG8_WAIT_L(0); PG8_MMA(1, 0, At, B0); PG8_BAR; PG8_SCHED;
            PG8_STAGE(PG8_SB(1, 1), b3 + hstepB, voffB);
            PG8_WAIT_V(6); PG8_BAR; PG8_MMA(1, 1, At, B1); PG8_BAR;
            }
        }
        if constexpr (ALIGN_EPI) { if (wr == 0) PG8_BAR; }
        if constexpr (!Epi::AFTER_DRAIN) { E(acc, cur, wr, wc, fr, fq); }
        if (!has_next) break;
#pragma unroll
        for (int a = 0; a < 2; ++a)
#pragma unroll
            for (int b = 0; b < 2; ++b)
#pragma unroll
                for (int m = 0; m < 4; ++m)
#pragma unroll
                    for (int n = 0; n < 2; ++n) acc[a][b][m][n] = (f32x4){0.f, 0.f, 0.f, 0.f};
        cur = nxt; cA = nA; cB = nB; ++ui;
        if constexpr (ALIGN_EPI) { if (wr == 1) PG8_BAR; }
    }
    PG8_WAIT_V(0);
    if constexpr (!ALIGN_EPI) { if (wr == 0) PG8_BAR; }
    PG8_BAR;
    if constexpr (Epi::AFTER_DRAIN) { E.fused(acc, cur, wr, wc, fr, fq, lds, wid, lane); }
#undef PG8_SA
#undef PG8_SB
#undef PG8_STAGE
#undef PG8_LDA
#undef PG8_LDB
#undef PG8_MMA
#undef PG8_WAIT_V
#undef PG8_WAIT_L
#undef PG8_BAR
#undef PG8_SCHED
}
}

namespace moba {
typedef short s16x4 __attribute__((ext_vector_type(4)));
typedef short s16x8 __attribute__((ext_vector_type(8)));
constexpr int D = 64, PIN = DIN, POUT = DM;
constexpr int NW = 8, QBLK = 32, QB = QBLK * NW, KVBLK = 64;
__device__ __forceinline__ int crow(int r, int hi) { return (r & 3) + 8 * (r >> 2) + 4 * hi; }
#define SBAR() __builtin_amdgcn_sched_barrier(0)
__device__ __forceinline__ void cmask(f32x16& p0, f32x16& p1, int jb, int qrel, int hi) {
    const float NEG = -INFINITY; int kb = 64 * jb + 4 * hi;
#pragma unroll
    for (int r = 0; r < 16; ++r) { int kv = kb + (r & 3) + 8 * (r >> 2); if (kv > qrel) p0[r] = NEG; if (kv + 32 > qrel) p1[r] = NEG; }
}
constexpr int NSLOT = 3, SLOTB = 8192;
constexpr int LDS_K = 0, LDS_V = NSLOT * SLOTB, LDS_WS = 2 * NSLOT * SLOTB, LDS_OST = LDS_WS + NW * 64 * 4, LDS_BYTES = LDS_OST + NW * 4096;
constexpr float BIG = 60000.f;
__device__ __forceinline__ void glds16(const void* gsrc, unsigned lds_dst) { unsigned keep;
    asm volatile("s_mov_b32 %0, m0\n\ts_mov_b32 m0, %2\n\ts_nop 0\n\tglobal_load_lds_dwordx4 %1, off\n\ts_mov_b32 m0, %0" : "=&s"(keep) : "v"(gsrc), "s"(lds_dst) : "memory"); }
__device__ __forceinline__ float max3f(float a, float b, float c) { float r; asm("v_max3_f32 %0, %1, %2, %3" : "=v"(r) : "v"(a), "v"(b), "v"(c)); return r; }
__device__ __forceinline__ float max2f(float a, float b) { float r; asm("v_max_f32_e32 %0, %1, %2" : "=v"(r) : "v"(a), "v"(b)); return r; }
__device__ __forceinline__ float fadd_s(float a, float b) { float r; asm("v_add_f32_e32 %0, %1, %2" : "=v"(r) : "v"(a), "v"(b)); return r; }
__device__ __forceinline__ float fsub_s(float a, float b) { float r; asm("v_sub_f32_e32 %0, %1, %2" : "=v"(r) : "v"(a), "v"(b)); return r; }
#define WAIT_BAR(N) asm volatile("s_waitcnt vmcnt(" #N ") lgkmcnt(0)\n\ts_barrier" ::: "memory")
#define MFMA32(a, b, c) __builtin_amdgcn_mfma_f32_32x32x16_f16(a, b, c, 0, 0, 0)
__device__ __forceinline__ void qkt(f32x16& p0, f32x16& p1, const char* Kslot, const h8* qr, const f32x16& c0, const f32x16& c1, int r32, int hi) {
    const char* kb = Kslot + hi * 1024 + r32 * 16;
#pragma unroll
    for (int d0 = 0; d0 < 4; ++d0) {
        const h8 b0 = *reinterpret_cast<const h8*>(kb + d0 * 2048);
        const h8 b1 = *reinterpret_cast<const h8*>(kb + d0 * 2048 + 512);
        if (d0 == 0) { p0 = MFMA32(b0, qr[0], c0); p1 = MFMA32(b1, qr[0], c1); }
        else { p0 = MFMA32(b0, qr[d0], p0); p1 = MFMA32(b1, qr[d0], p1); } }
}
typedef __attribute__((address_space(3))) const char* lds_cptr;
typedef short v4i16_t __attribute__((ext_vector_type(4)));
#define LDSH8(p) (*(const __attribute__((address_space(3))) h8*)(p))
__device__ __forceinline__ void kload8(h8* kf, lds_cptr kp) {
    kf[0] = LDSH8(kp); kf[1] = LDSH8(kp + 512); kf[2] = LDSH8(kp + 2048); kf[3] = LDSH8(kp + 2560);
    kf[4] = LDSH8(kp + 4096); kf[5] = LDSH8(kp + 4608); kf[6] = LDSH8(kp + 6144); kf[7] = LDSH8(kp + 6656);
}
__device__ __forceinline__ void kload2(h8* kf, lds_cptr kp, int j) { kf[2 * j] = LDSH8(kp + j * 2048); kf[2 * j + 1] = LDSH8(kp + j * 2048 + 512); }
__device__ __forceinline__ s16x4 vtr(lds_cptr p) { return __builtin_bit_cast(s16x4, __builtin_amdgcn_ds_read_tr16_b64_v4i16((__attribute__((address_space(3))) v4i16_t*)p)); }
__device__ __forceinline__ h8 mk8(s16x4 lo, s16x4 hi) { s16x8 v = {lo[0], lo[1], lo[2], lo[3], hi[0], hi[1], hi[2], hi[3]}; return __builtin_bit_cast(h8, v); }
__device__ __forceinline__ float rowmax(const f32x16& p0, const f32x16& p1) {
    float a = max3f(p0[0], p0[1], p1[0]), b = max3f(p0[2], p0[3], p1[1]); a = max3f(a, p1[2], p1[3]);
#pragma unroll
    for (int r = 4; r < 16; r += 4) { a = max3f(a, p0[r], p0[r + 1]); b = max3f(b, p0[r + 2], p0[r + 3]); a = max3f(a, p1[r], p1[r + 1]); b = max3f(b, p1[r + 2], p1[r + 3]); }
    const float m = max2f(a, b);
    auto rr = __builtin_amdgcn_permlane32_swap(__float_as_uint(m), __float_as_uint(m), false, false);
    return max2f(__uint_as_float(rr[0]), __uint_as_float(rr[1]));
}
__device__ __forceinline__ void pv(f32x16* o, int vb, h8 pa0, h8 pa1, h8 pa2, h8 pa3) {
#pragma unroll
    for (int d0 = 0; d0 < 2; ++d0) { s16x4 lo[4], hi[4];
#pragma unroll
        for (int ks = 0; ks < 4; ++ks) {
            asm volatile("ds_read_b64_tr_b16 %0,%1 offset:%c2" : "=&v"(lo[ks]) : "v"(vb), "i"(d0 * 4096 + ks * 1024) : "memory");
            asm volatile("ds_read_b64_tr_b16 %0,%1 offset:%c2" : "=&v"(hi[ks]) : "v"(vb), "i"(d0 * 4096 + ks * 1024 + 512) : "memory"); }
        asm volatile("s_waitcnt lgkmcnt(0)" ::: "memory"); SBAR();
        o[d0] = MFMA32(pa0, mk8(lo[0], hi[0]), o[d0]);
        o[d0] = MFMA32(pa1, mk8(lo[1], hi[1]), o[d0]);
        o[d0] = MFMA32(pa2, mk8(lo[2], hi[2]), o[d0]);
        o[d0] = MFMA32(pa3, mk8(lo[3], hi[3]), o[d0]);
    }
}

template <int THRL> __device__ __forceinline__ void attn_unit(int b, int h, int qb, const u16* PROJ, const float* KMEAN, u16* MIX, char* shm, const int wid) {
    const int lane = fresh_lane(), r32 = lane & 31, hi = lane >> 5;
    const long rowbase = (long)b * SEQ; const int q0 = qb * QB;
    const u16* Qw = PROJ + (rowbase + q0 + wid * QBLK) * PIN + h * D;
    const u16* Kh = PROJ + rowbase * PIN + 512 + h * D; const u16* Vh = PROJ + rowbase * PIN + 1024 + h * D;
    const unsigned lds0 = (unsigned)(uintptr_t)shm;
    float* wsf = (float*)(shm + LDS_WS) + wid * 64;
    const u16* ksrc = Kh + (long)lane * PIN + wid * 8;
    const u16* vsrc = Vh + (long)(16 * (wid & 3) + (lane >> 2)) * PIN + (wid >> 2) * 32 + (lane & 3) * 8;
    const unsigned kdst = lds0 + LDS_K + wid * 1024, vdst = lds0 + LDS_V + wid * 1024;
#define KT(t) (((t) < 4) ? (4 * qb + (t)) : ((t) - 4))
#define DMA_K(t, slot) glds16(ksrc + (long)KT(t) * KVBLK * PIN, (unsigned)__builtin_amdgcn_readfirstlane(kdst + (slot)))
#define DMA_V(t, slot) glds16(vsrc + (long)KT(t) * KVBLK * PIN, (unsigned)__builtin_amdgcn_readfirstlane(vdst + (slot)))
    const int vb0 = (int)(lds0 + LDS_V) + ((lane >> 4) & 1) * 32 + (lane & 3) * 8 + (4 * hi + ((lane & 15) >> 2)) * 64;
    const char* Kbase = shm + LDS_K; h8 kf[8];
    const lds_cptr shm3 = (lds_cptr)shm; const lds_cptr kp0 = shm3 + LDS_K + hi * 1024 + r32 * 16; const lds_cptr vp0 = shm3 + LDS_V + ((lane >> 4) & 1) * 32 + (lane & 3) * 8 + (4 * hi + ((lane & 15) >> 2)) * 64;
    const int NT = 4 * (qb + 1);
    DMA_K(0, 0); DMA_V(0, 0); DMA_K(1, SLOTB);
    h8 qr[4];
#pragma unroll
    for (int d0 = 0; d0 < 4; ++d0) qr[d0] = *reinterpret_cast<const h8*>(&Qw[(long)r32 * PIN + d0 * 16 + hi * 8]);
    unsigned selmask = 0u;
    {
        const float* kmb = KMEAN + (size_t)b * NBLK * 512 + h * D + 8 * hi;
        float v1 = -INFINITY, v2 = -INFINITY, v3 = -INFINITY; int i1 = -1, i2 = -1, i3 = -1;
        for (int n = 0; n < qb; ++n) { const float* kp = kmb + n * 512; float a = 0.f;
#pragma unroll
            for (int d0 = 0; d0 < 4; ++d0) { const f32x4 x0 = *(const f32x4*)(kp + 16 * d0), x1 = *(const f32x4*)(kp + 16 * d0 + 4);
                a += (float)qr[d0][0] * x0[0] + (float)qr[d0][1] * x0[1] + (float)qr[d0][2] * x0[2] + (float)qr[d0][3] * x0[3]
                   + (float)qr[d0][4] * x1[0] + (float)qr[d0][5] * x1[1] + (float)qr[d0][6] * x1[2] + (float)qr[d0][7] * x1[3]; }
            a += __shfl_xor(a, 32);
            if (a > v1) { v3 = v2; i3 = i2; v2 = v1; i2 = i1; v1 = a; i1 = n; }
            else if (a > v2) { v3 = v2; i3 = i2; v2 = a; i2 = n; }
            else if (a > v3) { v3 = a; i3 = n; } }
        if (i1 >= 0) selmask |= 1u << i1; if (i2 >= 0) selmask |= 1u << i2; if (i3 >= 0) selmask |= 1u << i3;
    }
#define SGPRF(x) __builtin_bit_cast(float, __builtin_amdgcn_readfirstlane(__builtin_bit_cast(int, (float)(x))))
    const float slope2 = SGPRF(__builtin_amdgcn_exp2f(-(float)(h + 1)) * LOG2E), c32 = SGPRF(32.f * slope2);
    const float s1_ = slope2, s2_ = SGPRF(2.f * slope2), s3_ = SGPRF(3.f * slope2), s8_ = SGPRF(8.f * slope2), s16_ = SGPRF(16.f * slope2), s24_ = SGPRF(24.f * slope2);
    const float hi4 = hi ? 4.f * slope2 : 0.f;
    const int qrel = wid * QBLK + r32, qpos = q0 + qrel;
    float mhat = 0.f, l_reg = 0.f; f32x16 o[2]; o[0] = f32x16{}; o[1] = f32x16{};
#define CMASK(P0, P1, t) do { if ((t) < 4) cmask(P0, P1, (t), qrel, hi); } while (0)
#define CINIT(C0, C1, t) do { const bool sel_ = ((t) < 4) || (((selmask >> (((t) - 4) >> 2)) & 1u) != 0u); \
        const float base_ = (sel_ ? (slope2 * (float)(64 * KT(t) - qpos) - mhat) : -BIG) + hi4; \
        const float g0_ = base_, g1_ = base_ + s8_, g2_ = base_ + s16_, g3_ = base_ + s24_; \
        C0[0] = g0_; C0[1] = g0_ + s1_; C0[2] = g0_ + s2_; C0[3] = g0_ + s3_; C0[4] = g1_; C0[5] = g1_ + s1_; C0[6] = g1_ + s2_; C0[7] = g1_ + s3_; \
        C0[8] = g2_; C0[9] = g2_ + s1_; C0[10] = g2_ + s2_; C0[11] = g2_ + s3_; C0[12] = g3_; C0[13] = g3_ + s1_; C0[14] = g3_ + s2_; C0[15] = g3_ + s3_; \
        _Pragma("unroll") for (int r = 0; r < 16; ++r) { C1[r] = C0[r] + c32; } } while (0)
    bool resc = false;
#define START(P0, P1) do { const float rm = rowmax(P0, P1); resc = false; \
    { const float dl = rm; mhat = fadd_s(mhat, dl); \
      _Pragma("unroll") for (int r = 0; r < 16; ++r) { P0[r] = fsub_s(P0[r], dl); P1[r] = fsub_s(P1[r], dl); } } \
    _Pragma("unroll") for (int r = 0; r < 16; ++r) P0[r] = __builtin_amdgcn_exp2f(P0[r]); } while (0)
#define RESC() do { if (resc) { asm volatile("s_waitcnt lgkmcnt(0)" ::: "memory"); \
      _Pragma("unroll") for (int d_ = 0; d_ < 2; ++d_) _Pragma("unroll") for (int r = 0; r < 16; ++r) o[d_][r] *= wsf[crow(r, hi)]; } } while (0)
    f32x16 pA0, pA1, pB0, pB1;
    int sl_prev = 0, sl_cur = 0, sl_next = SLOTB;
#define ROT() do { sl_prev = sl_cur; sl_cur = sl_next; sl_next = (sl_next == (NSLOT - 1) * SLOTB) ? 0 : sl_next + SLOTB; } while (0)
    DMA_K(2, 2 * SLOTB);
    WAIT_BAR(3);
    CINIT(pB0, pB1, 0);
    qkt(pA0, pA1, Kbase, qr, pB0, pB1, r32, hi); asm volatile("s_nop 15\n\ts_nop 7" : "+v"(pA0), "+v"(pA1)); CMASK(pA0, pA1, 0);
    START(pA0, pA1);
    _Pragma("unroll") for (int r = 0; r < 16; ++r) pA1[r] = __builtin_amdgcn_exp2f(pA1[r]);
    WAIT_BAR(0);
    DMA_K(3, 0); DMA_V(1, SLOTB);
    ROT();
    kload8(kf, kp0 + sl_cur);
    WAIT_BAR(2);
    s16x4 vlo[8], vhi[8]; u32x4 pw0, pw1, pw2, pw3;
#define PKW(P, B) pk2h(P[B], P[B + 1])
#define PAF(k) __builtin_bit_cast(h8, pw##k)
#define VFR(i) mk8(vlo[i], vhi[i])
#define PINV(x) asm volatile("" : "+v"(x))
#define MX3(a, b, c) __builtin_fmaxf(__builtin_fmaxf((a), (b)), (c))
#define GAPA(MF, A0, A1, A2, A3, W0, W1, PW) do { MF; sacc += A0; sacc += A1; sacc += A2; sacc += A3; PINV(sacc); W0; W1; PINV(PW); SBAR(); } while (0)
#define EX(v) __builtin_amdgcn_exp2f(v)
#define GAPB(MF, X, B) do { MF; X[B] = EX(X[B]); X[B + 1] = EX(X[B + 1]); X[B + 2] = EX(X[B + 2]); X[B + 3] = EX(X[B + 3]); PINV(X); SBAR(); } while (0)
#define VRD(i) do { vlo[i] = vtr(vp_ + (((i) >> 2) * 4096 + ((i) & 3) * 1024)); vhi[i] = vtr(vp_ + (((i) >> 2) * 4096 + ((i) & 3) * 1024 + 512)); } while (0)
#define KRD(G, j) do { if (G) { kload2(kf, kp0 + sl_next, j); SBAR(); } } while (0)
#define STEP(C0, C1, P0, P1, t, GK, GV, GL) do { SBAR(); \
    CINIT(C0, C1, t); PINV(C0); PINV(C1); SBAR(); \
    const lds_cptr vp_ = vp0 + sl_prev; \
    VRD(0); SBAR(); float sacc = (P0[0] + P0[1]); \
    GAPA(C0 = MFMA32(kf[0], qr[0], C0), P0[2], P0[3], P0[4], P0[5],     pw0[0] = PKW(P0, 0), pw0[1] = PKW(P0, 2), pw0); \
    VRD(4); SBAR(); GAPA(C1 = MFMA32(kf[1], qr[0], C1), P0[6], P0[7], P0[8], P0[9],     pw0[2] = PKW(P0, 4), pw0[3] = PKW(P0, 6), pw0); \
    VRD(1); SBAR(); GAPA(C0 = MFMA32(kf[2], qr[1], C0),   P0[10], P0[11], P0[12], P0[13], pw1[0] = PKW(P0, 8), pw1[1] = PKW(P0, 10), pw1); \
    VRD(5); SBAR(); GAPA(C1 = MFMA32(kf[3], qr[1], C1),   P0[14], P0[15], P1[0], P1[1],   pw1[2] = PKW(P0, 12), pw1[3] = PKW(P0, 14), pw1); \
    VRD(2); SBAR(); GAPA(C0 = MFMA32(kf[4], qr[2], C0),   P1[2], P1[3], P1[4], P1[5],     pw2[0] = PKW(P1, 0), pw2[1] = PKW(P1, 2), pw2); \
    VRD(6); SBAR(); GAPA(C1 = MFMA32(kf[5], qr[2], C1),   P1[6], P1[7], P1[8], P1[9],     pw2[2] = PKW(P1, 4), pw2[3] = PKW(P1, 6), pw2); \
    VRD(3); SBAR(); GAPA(C0 = MFMA32(kf[6], qr[3], C0),   P1[10], P1[11], P1[12], P1[13], pw3[0] = PKW(P1, 8), pw3[1] = PKW(P1, 10), pw3); \
    VRD(7); SBAR(); GAPA(C1 = MFMA32(kf[7], qr[3], C1),   P1[14], P1[15], 0.f, 0.f,       pw3[2] = PKW(P1, 12), pw3[3] = PKW(P1, 14), pw3); \
    l_reg += sacc; \
    if (GK) { DMA_K((t) + 3, sl_cur); } if (GV) { DMA_V((t) + 1, sl_next); } \
    CMASK(C0, C1, t); \
    { float a = MX3(C0[0], C0[1], C1[0]), b_ = MX3(C0[2], C0[3], C1[1]); a = MX3(a, C1[2], C1[3]); \
      _Pragma("unroll") for (int r = 4; r < 16; r += 4) { a = MX3(a, C0[r], C0[r + 1]); b_ = MX3(b_, C0[r + 2], C0[r + 3]); a = MX3(a, C1[r], C1[r + 1]); b_ = MX3(b_, C1[r + 2], C1[r + 3]); } \
      float rm = __builtin_fmaxf(a, b_); { auto rr = __builtin_amdgcn_permlane32_swap(__float_as_uint(rm), __float_as_uint(rm), false, false); rm = __builtin_fmaxf(__uint_as_float(rr[0]), __uint_as_float(rr[1])); } \
      resc = false; \
      if (__builtin_expect(__any(rm > (float)THRL), 0)) { const float dl = __builtin_fmaxf(rm, 0.f); mhat += dl; \
        _Pragma("unroll") for (int r = 0; r < 16; ++r) { C0[r] -= dl; C1[r] -= dl; } \
        const float f = __builtin_amdgcn_exp2f(-dl); l_reg *= f; if (hi == 0) wsf[r32] = f; resc = true; } } \
    SBAR(); \
    GAPB(o[0] = MFMA32(PAF(0), VFR(0), o[0]), C0, 0); \
    GAPB(o[1] = MFMA32(PAF(0), VFR(4), o[1]), C0, 4); \
    KRD(GL, 0); GAPB(o[0] = MFMA32(PAF(1), VFR(1), o[0]), C0, 8); \
    KRD(GL, 1); GAPB(o[1] = MFMA32(PAF(1), VFR(5), o[1]), C0, 12); \
    KRD(GL, 2); GAPB(o[0] = MFMA32(PAF(2), VFR(2), o[0]), C1, 0); \
    KRD(GL, 3); GAPB(o[1] = MFMA32(PAF(2), VFR(6), o[1]), C1, 4); \
    GAPB(o[0] = MFMA32(PAF(3), VFR(3), o[0]), C1, 8); \
    GAPB(o[1] = MFMA32(PAF(3), VFR(7), o[1]), C1, 12); \
    } while (0)
#define ENDW(tt) do { if ((tt) + 3 < NT) { WAIT_BAR(2); } else if ((tt) + 2 < NT) { WAIT_BAR(1); } else { WAIT_BAR(0); } } while (0)
    int t = 1;
    for (; t + 1 < NT; t += 2) {
        STEP(pB0, pB1, pA0, pA1, t, (t + 3 < NT), (t + 1 < NT), (t + 1 < NT));       ENDW(t);     RESC(); ROT();
        STEP(pA0, pA1, pB0, pB1, t + 1, (t + 4 < NT), (t + 2 < NT), (t + 2 < NT));   ENDW(t + 1); RESC(); ROT();
    }
    STEP(pB0, pB1, pA0, pA1, NT - 1, false, false, false); RESC();
    { float sacc = pB0[0] + pB0[1]; _Pragma("unroll") for (int r = 2; r < 16; ++r) sacc += pB0[r]; _Pragma("unroll") for (int r = 0; r < 16; ++r) sacc += pB1[r]; l_reg += sacc;
      pw0 = (u32x4){PKW(pB0, 0), PKW(pB0, 2), PKW(pB0, 4), PKW(pB0, 6)}; pw1 = (u32x4){PKW(pB0, 8), PKW(pB0, 10), PKW(pB0, 12), PKW(pB0, 14)};
      pw2 = (u32x4){PKW(pB1, 0), PKW(pB1, 2), PKW(pB1, 4), PKW(pB1, 6)}; pw3 = (u32x4){PKW(pB1, 8), PKW(pB1, 10), PKW(pB1, 12), PKW(pB1, 14)};
      SBAR(); pv(o, vb0 + sl_cur, PAF(0), PAF(1), PAF(2), PAF(3)); }
    { auto rr = __builtin_amdgcn_permlane32_swap(__float_as_uint(l_reg), __float_as_uint(l_reg), false, false); l_reg = __uint_as_float(rr[0]) + __uint_as_float(rr[1]); }
    if (hi == 0) wsf[32 + r32] = l_reg; asm volatile("s_waitcnt lgkmcnt(0)" ::: "memory");
    float rli[16];
#pragma unroll
    for (int r = 0; r < 16; ++r) rli[r] = __builtin_amdgcn_rcpf(wsf[32 + crow(r, hi)]);
    u16* Ow = MIX + (rowbase + q0 + wid * QBLK) * POUT + h * D;
    { u16* stg = (u16*)(shm + LDS_OST) + wid * 2048;
#pragma unroll
      for (int r = 0; r < 16; ++r) { const int orow = crow(r, hi);
#pragma unroll
        for (int d0 = 0; d0 < 2; ++d0) stg[orow * 64 + d0 * 32 + r32] = f2h(o[d0][r] * rli[r]); }
      asm volatile("s_waitcnt lgkmcnt(0)" ::: "memory");
#pragma unroll
      for (int i = 0; i < 4; ++i) { const int row = i * 8 + (lane >> 3), ch = lane & 7; const u32x4 v = *(const u32x4*)(stg + row * 64 + ch * 8); *(u32x4*)(Ow + (long)row * POUT + ch * 8) = v; } }
    asm volatile("s_waitcnt lgkmcnt(0)\n\ts_barrier" ::: "memory");
#undef SGPRF
#undef KT
#undef DMA_K
#undef DMA_V
#undef CMASK
#undef CINIT
#undef START
#undef RESC
#undef ROT
#undef PKW
#undef PAF
#undef VFR
#undef PINV
#undef MX3
#undef GAPA
#undef GAPB
#undef EX
#undef VRD
#undef KRD
#undef STEP
#undef ENDW
}
#undef SBAR
#undef WAIT_BAR
#undef MFMA32
#undef LDSH8
}

namespace poolu {
constexpr int RS = 272;
constexpr int LDS_D = 0, LDS_W = 256 * RS, LDS_BYTES = LDS_W + 128 * RS;
__device__ __forceinline__ void pool_unit(int pm, int g, const u16* PROJ, const u16* WPT, const float* pool_scale, u16* MIX, unsigned char* shm, const int wid) {
    const int lane = fresh_lane(), tid = wid * 64 + lane;
    const int w = 2 << g;
#pragma unroll
    for (int i = 0; i < 4; ++i) { const int e = tid + 512 * i, d = e >> 4, ch = e & 15;
        *(u32x4*)(shm + LDS_W + d * RS + ch * 16) = *(const u32x4*)(WPT + (size_t)d * 512 + g * 128 + ch * 8); }
    { const int ch = tid & 15, run = tid >> 4, t0 = (pm & 15) * 256 + run * 8;
      const u16* pcol = PROJ + (size_t)(pm >> 4) * SEQ * DIN + 1536 + g * 128 + ch * 8;
      float sacc[8];
#pragma unroll
      for (int j = 0; j < 8; ++j) sacc[j] = 0.f;
      for (int p = max(0, t0 - w + 1); p < t0; ++p) { const h8 v = *(const h8*)(pcol + (size_t)p * DIN);
#pragma unroll
          for (int j = 0; j < 8; ++j) sacc[j] += (float)v[j]; }
#pragma unroll 1
      for (int i = 0; i < 8; ++i) { const int p = t0 + i; const h8 v = *(const h8*)(pcol + (size_t)p * DIN);
          const int lo = max(p + 1 - w, 0); const float inv = 1.0f / (float)(p + 1 - lo);
          u32x4 o; float dd[8];
#pragma unroll
          for (int j = 0; j < 8; ++j) { sacc[j] += (float)v[j]; dd[j] = sacc[j] * inv - (float)v[j]; }
          o.x = pk2h(dd[0], dd[1]); o.y = pk2h(dd[2], dd[3]); o.z = pk2h(dd[4], dd[5]); o.w = pk2h(dd[6], dd[7]);
          *(u32x4*)(shm + LDS_D + (run * 8 + i) * RS + ch * 16) = o;
          if (p + 1 - w >= 0) { const h8 vo = *(const h8*)(pcol + (size_t)(p + 1 - w) * DIN);
#pragma unroll
              for (int j = 0; j < 8; ++j) sacc[j] -= (float)vo[j]; } } }
    __syncthreads();
    const int fr = lane & 15, fq = lane >> 4;
    f32x4 acc[2][8];
#pragma unroll
    for (int m = 0; m < 2; ++m)
#pragma unroll
        for (int n = 0; n < 8; ++n) acc[m][n] = (f32x4){0.f, 0.f, 0.f, 0.f};
#pragma unroll
    for (int k = 0; k < 4; ++k) { h8 af[2];
#pragma unroll
        for (int m = 0; m < 2; ++m) af[m] = *(const h8*)(shm + LDS_D + (wid * 32 + m * 16 + fr) * RS + (k * 32 + fq * 8) * 2);
#pragma unroll
        for (int n = 0; n < 8; ++n) { const h8 bf = *(const h8*)(shm + LDS_W + (n * 16 + fr) * RS + (k * 32 + fq * 8) * 2);
#pragma unroll
            for (int m = 0; m < 2; ++m) acc[m][n] = __builtin_amdgcn_mfma_f32_16x16x32_f16(bf, af[m], acc[m][n], 0, 0, 0); } }
#pragma unroll
    for (int n = 0; n < 8; ++n) { const f32x4 sc = *(const f32x4*)(pool_scale + g * 128 + n * 16 + 4 * fq);
#pragma unroll
        for (int m = 0; m < 2; ++m) { const f32x4 y = acc[m][n] * sc; u32x2 o; o.x = pk2h(y[0], y[1]); o.y = pk2h(y[2], y[3]);
            *(u32x2*)(MIX + (size_t)(pm * 256 + wid * 32 + m * 16 + fr) * DM + 512 + g * 128 + n * 16 + 4 * fq) = o; } }
    __syncthreads();
}
}

#define LAS __attribute__((address_space(3)))
#define XB_TMO      128
#define XB_XCNT(j)  (256  + 64 * (j))
#define XB_XSUB(j)  (1280 + 64 * (j))
#define XB_XGEN(j)  (2304 + 64 * (j))
#define XB_TOP      3328
#define XB_TOPGEN   3392
#define XCD_BAR_WORDS 3456
#define XB_SPIN_CAP (1u << 18)
__device__ __forceinline__ unsigned xb_ld(unsigned* p)              { return __hip_atomic_load(p, __ATOMIC_RELAXED, __HIP_MEMORY_SCOPE_AGENT); }
__device__ __forceinline__ unsigned xb_add(unsigned* p, unsigned v) { return __hip_atomic_fetch_add(p, v, __ATOMIC_RELAXED, __HIP_MEMORY_SCOPE_AGENT); }
__device__ __forceinline__ unsigned xb_xcc_id() { return (unsigned)__builtin_amdgcn_s_getreg((3 << 11) | 20) & 0xFu; }
#define XB_SPIN(cond, bar) do { unsigned _sp = 0; while (cond) { __builtin_amdgcn_s_sleep(1); \
    if ((++_sp & 255u) == 0u) { if (xb_ld(&(bar)[XB_TMO])) break; if (_sp > XB_SPIN_CAP) { atomicAdd(&(bar)[XB_TMO], 1u); break; } } } } while (0)
struct XcdBarrier { unsigned* bar; unsigned x; volatile LAS unsigned* st; };
__device__ __forceinline__ XcdBarrier xcd_barrier_post(unsigned* bar, volatile LAS unsigned* st) {
    XcdBarrier b; b.bar = bar; b.x = xb_xcc_id(); b.st = st;
    if (threadIdx.x == 0) (void)xb_add(&bar[XB_XCNT(b.x)], 1u);
    return b;
}
__device__ __forceinline__ void xcd_barrier_complete(unsigned* bar, unsigned x, unsigned& nloc, unsigned& nx) {
    const unsigned G = gridDim.x * gridDim.y * gridDim.z;
    unsigned sum, cnt, mine, sp = 0u;
    for (;;) {
        sum = 0u; cnt = 0u; mine = 0u;
#pragma unroll
        for (unsigned j = 0; j < 16; ++j) { const unsigned c = xb_ld(&bar[XB_XCNT(j)]); sum += c; cnt += (c > 0u) ? 1u : 0u; mine = (j == x) ? c : mine; }
        if (sum == G) break;
        __builtin_amdgcn_s_sleep(1);
        if ((++sp & 255u) == 0u) { if (xb_ld(&bar[XB_TMO])) break; if (sp > XB_SPIN_CAP) { atomicAdd(&bar[XB_TMO], 1u); break; } }
    }
    nloc = mine > 0u ? mine : 1u; nx = cnt > 0u ? cnt : 1u;
}
__device__ __forceinline__ void xcd_barrier(const XcdBarrier& b) {
    asm volatile("s_waitcnt vmcnt(0)" ::: "memory");
    __syncthreads();
    if (threadIdx.x == 0) {
        unsigned* bar = b.bar;
        __builtin_amdgcn_s_waitcnt(0);
        unsigned nloc = b.st[0], nx = b.st[1];
        if (nloc == 0u) { xcd_barrier_complete(bar, b.x, nloc, nx); b.st[0] = nloc; b.st[1] = nx; }
        const unsigned old = xb_add(&bar[XB_XSUB(b.x)], 1u);
        const unsigned gen = old / nloc;
        if (old + 1u == (gen + 1u) * nloc) {
            __builtin_amdgcn_fence(__ATOMIC_RELEASE, "agent");
            asm volatile("s_waitcnt vmcnt(0)" ::: "memory");
            const unsigned og = xb_add(&bar[XB_TOP], 1u);
            const unsigned tg = og / nx;
            if (og + 1u == (tg + 1u) * nx) xb_add(&bar[XB_TOPGEN], 1u);
            else XB_SPIN(xb_ld(&bar[XB_TOPGEN]) == tg, bar);
            __builtin_amdgcn_fence(__ATOMIC_ACQUIRE, "agent");
            xb_add(&bar[XB_XGEN(b.x)], 1u);
            asm volatile("s_waitcnt vmcnt(0)" ::: "memory");
        } else {
            XB_SPIN(xb_ld(&bar[XB_XGEN(b.x)]) == gen, bar);
            __builtin_amdgcn_fence(__ATOMIC_ACQUIRE, "agent");
            asm volatile("s_waitcnt vmcnt(0)" ::: "memory");
        }
    }
    __syncthreads();
}
constexpr int CW_BAR = 4096;
constexpr int MISC_OFF = 131072 + 320;

namespace cg = cooperative_groups;
constexpr int NWAVES = 8, NTHREADS = NWAVES * 64;
constexpr int LDS_BYTES = 147456;
struct Args { Ptrs p; };

__global__ void __launch_bounds__(NTHREADS, 2) mega(Args args) {
    extern __shared__ __attribute__((aligned(16))) unsigned char lds[];
    cg::grid_group grid = cg::this_grid();
    const Ptrs& P = args.p;
    unsigned char* ws = P.ws;
    const int wave = __builtin_amdgcn_readfirstlane((int)threadIdx.x >> 6);
#define lane fresh_lane()
    const int G = gridDim.x, gw = blockIdx.x * NWAVES + wave, NGW = G * NWAVES;
    float* wl = (float*)(lds + wave * 16384);
    u16 *XN = (u16*)(ws + WS_XN), *ACT = (u16*)(ws + WS_ACT), *PROJ = (u16*)(ws + WS_PROJ), *MIX = (u16*)(ws + WS_MIX), *XQ = (u16*)(ws + WS_XQ), *XAO = (u16*)(ws + WS_XAO);
    u16* XP = (u16*)(ws + WS_XP);
    u16 *MEMN = (u16*)(ws + WS_MEMN), *KMEM = (u16*)(ws + WS_KMEM), *VMEMT = (u16*)(ws + WS_VMEMT);
    float *F32A = (float*)(ws + WS_F32A), *F32B = (float*)(ws + WS_F32B), *KMEAN = (float*)(ws + WS_KMEAN), *OUT = P.out;
    { volatile LAS unsigned* misc = (volatile LAS unsigned*)((LAS unsigned char*)lds + MISC_OFF); if (threadIdx.x < 32) misc[threadIdx.x] = 0u; }
    __syncthreads();
    XcdBarrier xbar = xcd_barrier_post((unsigned*)(ws + WS_CTL) + CW_BAR, (volatile LAS unsigned*)((LAS unsigned char*)lds + MISC_OFF) + 8);
#define GSYNC() xcd_barrier(xbar)
    PG8_LAS unsigned char* ldsl = (PG8_LAS unsigned char*)lds;
#define DENSE(EPI, epi, Aptr, lda_, Btptr, ldb_, nM_, nN_, K_, ALIGN) do { pg8::DenseOrder S_; S_.init(nM_, nN_, G, (int)blockIdx.x); S_.A = (Aptr); S_.Bt = (Btptr); S_.lda = (lda_); S_.ldb = (ldb_); \
        pg8::gemm_phase<EPI, pg8::DenseOrder, ALIGN, true>(ldsl, pg8::Gemm{K_, lda_, ldb_}, S_, epi, wave); } while (0)
    prologue(P, gw, NGW, lane, wl);
    grid.sync();
    { pg8::EpiSwiGLU e{ACT, DFF}; DENSE(pg8::EpiSwiGLU, e, XN, DM, (u16*)(ws + WS_W1A), DM, M / 256, 2 * DFF / 256, DM, true); }
    { pg8::EpiF16 e{KMEM, DM, 1.f, 0}; DENSE(pg8::EpiF16, e, MEMN, DM, (u16*)(ws + WS_WKV), DM, BATCH * NMEM / 256, DM / 256, DM, true); }
    for (int b = 0; b < BATCH; ++b) { pg8::EpiF16 e{VMEMT + (size_t)b * DM * NMEM, NMEM, 1.f, 0}; DENSE(pg8::EpiF16, e, (u16*)(ws + WS_WKV) + (size_t)DM * DM, DM, MEMN + (size_t)b * NMEM * DM, DM, DM / 256, NMEM / 256, DM, true); }
    GSYNC();
    { pg8::EpiF32 e{F32A, DM}; DENSE(pg8::EpiF32, e, ACT, DFF, (u16*)(ws + WS_W1D), DFF, M / 256, DM / 256, DFF, false); }
    GSYNC();
    nv_rownorm(gw, NGW, lane, F32A, P.in[0], 0.5f, P.in[6], OUT, P.in[7], XN);
    GSYNC();
    { pg8::EpiF16 e{PROJ, DIN, QSCALE, 2}; DENSE(pg8::EpiF16, e, XN, DM, (u16*)(ws + WS_WIN), DM, M / 256, DIN / 256, DM, true); }
    GSYNC();
    nv_kmean(gw, NGW, lane, PROJ, KMEAN);
    GSYNC();
    { const int vcu = ((int)blockIdx.x % 8) * (G / 8) + (int)blockIdx.x / 8, bh = vcu >> 3, sidx = vcu & 7;
      static_assert(moba::LDS_BYTES <= 131072, "attention LDS");
      moba::attn_unit<8>(bh / NH, bh % NH, sidx, PROJ, KMEAN, MIX, (char*)lds, wave);
      moba::attn_unit<8>(bh / NH, bh % NH, 15 - sidx, PROJ, KMEAN, MIX, (char*)lds, wave); }
    for (int pu = (int)blockIdx.x; pu < (M / 256) * 4; pu += G) poolu::pool_unit(pu >> 2, pu & 3, PROJ, (const u16*)(ws + WS_WPT), P.in[10], MIX, lds, wave);
    GSYNC();
    { pg8::EpiF32 e{F32B, DM}; DENSE(pg8::EpiF32, e, MIX, DM, (u16*)(ws + WS_WOUT), DM, M / 256, DM / 256, DM, false); }
    GSYNC();
    nv_rownorm(gw, NGW, lane, F32B, OUT, 1.0f, P.in[12], OUT, P.in[13], XN);
    GSYNC();
    { pg8::EpiF16 e{XQ, DM, XQSCALE, 4}; DENSE(pg8::EpiF16, e, XN, DM, (u16*)(ws + WS_WQ), DM, M / 256, DM / 256, DM, false); }
    asm volatile("s_waitcnt vmcnt(0)" ::: "memory"); __syncthreads();
    { pg8::EpiSoftmax e{XP, DM}; pg8::XOrder S_; S_.init(M / 256, XH, G, (int)blockIdx.x); S_.A = XQ; S_.B = KMEM; S_.lda = DM; S_.bb = (size_t)NMEM * DM; S_.bh = XHD;
      pg8::gemm_phase<pg8::EpiSoftmax, pg8::XOrder, false, true>(ldsl, pg8::Gemm{XHD, DM, DM}, S_, e, wave); }
    asm volatile("s_waitcnt vmcnt(0)" ::: "memory"); __syncthreads();
    { pg8::EpiF16 e{XAO, DM, 1.f, 0}; pg8::XOrder S_; S_.init(M / 256, XH, G, (int)blockIdx.x); S_.A = XP; S_.B = VMEMT; S_.lda = DM; S_.bb = (size_t)DM * NMEM; S_.bh = (size_t)XHD * NMEM;
      pg8::gemm_phase<pg8::EpiF16, pg8::XOrder, false, true>(ldsl, pg8::Gemm{NMEM, DM, NMEM}, S_, e, wave); }
    GSYNC();
    { pg8::EpiF32 e{F32B, DM}; DENSE(pg8::EpiF32, e, XAO, DM, (u16*)(ws + WS_WO), DM, M / 256, DM / 256, DM, false); }
    GSYNC();
    nv_rownorm(gw, NGW, lane, F32B, OUT, 1.0f, P.in[18], OUT, P.in[19], XN);
    GSYNC();
    { pg8::EpiSwiGLU e{ACT, DFF}; DENSE(pg8::EpiSwiGLU, e, XN, DM, (u16*)(ws + WS_W2A), DM, M / 256, 2 * DFF / 256, DM, true); }
    GSYNC();
    { pg8::EpiF32 e{F32A, DM}; DENSE(pg8::EpiF32, e, ACT, DFF, (u16*)(ws + WS_W2D), DFF, M / 256, DM / 256, DFF, false); }
    GSYNC();
    nv_rownorm(gw, NGW, lane, F32A, OUT, 0.5f, P.in[23], OUT, nullptr, nullptr);
#undef lane
}

extern "C" void kernel_launch(void* const* d_in, const int* in_sizes, int n_in, void* d_out, int out_size, void* d_ws, size_t ws_size, hipStream_t stream) {
    static int grid = 0;
    if (grid == 0) {
        if (n_in != 24 || out_size != M * DM || ws_size < WS_END) { fprintf(stderr, "kernel_launch: unexpected shapes (n_in %d out %d ws %zu)\n", n_in, out_size, ws_size); grid = -1; return; }
        int dev = 0, cus = 0, per_cu = 0;
        if (hipGetDevice(&dev) != hipSuccess || hipDeviceGetAttribute(&cus, hipDeviceAttributeMultiprocessorCount, dev) != hipSuccess) { grid = -1; return; }
        if (hipFuncSetAttribute((const void*)mega, hipFuncAttributeMaxDynamicSharedMemorySize, LDS_BYTES) != hipSuccess) { fprintf(stderr, "kernel_launch: hipFuncSetAttribute failed\n"); grid = -1; return; }
        if (hipOccupancyMaxActiveBlocksPerMultiprocessor(&per_cu, (const void*)mega, NTHREADS, LDS_BYTES) != hipSuccess || per_cu < 1) { fprintf(stderr, "kernel_launch: occupancy query failed (%d)\n", per_cu); grid = -1; return; }
        grid = cus * 1;
        fprintf(stderr, "kernel_launch: %d CUs, occupancy %d/CU, grid %d\n", cus, per_cu, grid);
    }
    if (grid < 0) return;
    (void)hipMemsetAsync((unsigned char*)d_ws + WS_CTL, 0, CTL_BYTES, stream);
    Args a{};
    for (int i = 0; i < 24; ++i) a.p.in[i] = (const float*)d_in[i];
    a.p.out = (float*)d_out; a.p.ws = (unsigned char*)d_ws;
    void* kargs[] = {&a};
    hipError_t e = hipLaunchCooperativeKernel((const void*)mega, dim3(grid), dim3(NTHREADS), kargs, LDS_BYTES, stream);
    if (e != hipSuccess) fprintf(stderr, "kernel_launch: cooperative launch failed: %s (grid %d)\n", hipGetErrorString(e), grid);
}
```
